# Optimizing an MI355X kernel written in HIP

```python
import math
import jax, jax.numpy as jnp
from jax import lax
import numpy as np

D_MODEL = 1024
BATCH = 8
SEQ = 2048
DEPTH = 4

RET_HEADS = 4
RET_DK = 128
RET_DV = 256
RET_CHUNK = 128
RET_THETA = 10000.0
DIL_HEADS = 8
DIL_HD = 64
DIL_PAIRS = ((128, 1), (512, 4), (2048, 16))
DIL_BLOCK = 128
ROPE_THETA = 500000.0
ROPE_DIMS = DIL_HD // 4
GDN_HEADS = 8
GDN_DK = 128
GDN_DV = 128
GDN_CHUNK = 64
GDN_CONV = 4
D_FF = 2816
FFN_CONV = 3
DN_ALPHA = (2.0 * DEPTH) ** 0.25
DN_BETA = (8.0 * DEPTH) ** -0.25
EPS = 1e-5
N_EVEN = (DEPTH + 1) // 2
N_ODD = DEPTH // 2

RET_QK_W = RET_HEADS * RET_DK
RET_V_W = RET_HEADS * RET_DV
DIL_W = DIL_HEADS * DIL_HD
EV_IN = 2 * RET_QK_W + 2 * RET_V_W + 3 * DIL_W
EV_MIX = RET_V_W + DIL_W
GDN_W = GDN_HEADS * GDN_DK
OD_IN = 4 * GDN_W + 2 * GDN_HEADS

kernel_name = "hybrid_retention_dilated_gdn_deepnorm"

F32 = jnp.float32


def _layernorm(x, g, b):
    xf = x.astype(F32)
    mu = jnp.mean(xf, -1, keepdims=True)
    var = jnp.mean(jnp.square(xf - mu), -1, keepdims=True)
    return ((xf - mu) * lax.rsqrt(var + EPS) * g.astype(F32) + b.astype(F32)).astype(x.dtype)


def _rms(xf):
    return xf * lax.rsqrt(jnp.mean(xf * xf, -1, keepdims=True) + EPS)


def _l2norm(xf):
    return xf * lax.rsqrt(jnp.sum(xf * xf, -1, keepdims=True) + 1e-6)


def _heads(t, n_heads):
    b, s, w = t.shape
    return t.reshape(b, s, n_heads, w // n_heads).transpose(0, 2, 1, 3)


def _merge(t):
    b, h, s, d = t.shape
    return t.transpose(0, 2, 1, 3).reshape(b, s, h * d)


def _rotary(x, positions, n_rot, theta):
    half = n_rot // 2
    inv = jnp.power(theta, -jnp.arange(half, dtype=F32) * 2.0 / n_rot)
    ang = positions.astype(F32)[:, None, :, None] * inv
    cos, sin = jnp.cos(ang), jnp.sin(ang)
    xf = x.astype(F32)
    x1, x2 = xf[..., :half], xf[..., half:n_rot]
    out = jnp.concatenate([x1 * cos - x2 * sin, x2 * cos + x1 * sin, xf[..., n_rot:]], -1)
    return out.astype(x.dtype)


def _causal_dwconv(x, w):
    k_w = w.shape[0]
    s = x.shape[1]
    xp = jnp.pad(x, ((0, 0), (k_w - 1, 0), (0, 0)))
    return sum(xp[:, j:j + s] * w[j] for j in range(k_w))


def _retention(q, k, v):
    b, h, s, dk = q.shape
    dv = v.shape[-1]
    c = RET_CHUNK
    n = s // c
    lg = jnp.log1p(-jnp.power(2.0, -5.0 - jnp.arange(h, dtype=F32)))
    idx = jnp.arange(c, dtype=F32)
    rel = idx[:, None] - idx[None, :]
    dmat = jnp.where(rel >= 0, jnp.exp(jnp.maximum(rel, 0.0) * lg[:, None, None]), 0.0)
    zeta = jnp.exp((c - 1 - idx) * lg[:, None])
    xi = jnp.exp((idx + 1) * lg[:, None])
    g_chunk = jnp.exp(c * lg)
    qc = q.reshape(b, h, n, c, dk)
    kc = k.reshape(b, h, n, c, dk)
    vc = v.reshape(b, h, n, c, dv)
    scores = jnp.einsum('bhnid,bhnjd->bhnij', qc, kc) * dmat[None, :, None]
    o_intra = jnp.einsum('bhnij,bhnje->bhnie', scores, vc)
    kv = jnp.einsum('bhnjd,bhnje->bhnde', kc * zeta[None, :, None, :, None], vc)

    def step(r_state, kv_n):
        return r_state * g_chunk[None, :, None, None] + kv_n, r_state

    _, r_prev = lax.scan(step, jnp.zeros((b, h, dk, dv), F32), jnp.moveaxis(kv, 2, 0))
    r_prev = jnp.moveaxis(r_prev, 0, 2)
    o_inter = jnp.einsum('bhnid,bhnde->bhnie', qc, r_prev) * xi[None, :, None, :, None]
    return (o_intra + o_inter).reshape(b, h, s, dv)


def _dilated_branch(q, k, v, window, dilation):
    b, h, s, hd = q.shape
    L = s // dilation
    wd = window // dilation
    qb_sz = DIL_BLOCK
    nb = -(-L // qb_sz)
    lp = nb * qb_sz

    def sub(t):
        t = t.reshape(b, h, L, dilation, hd).transpose(0, 1, 3, 2, 4)
        return jnp.pad(t, ((0, 0), (0, 0), (0, 0), (0, lp - L), (0, 0)))

    def band(t):
        tb = t.reshape(b, h, dilation, nb, qb_sz, hd)
        prev = jnp.pad(tb, ((0, 0), (0, 0), (0, 0), (1, 0), (0, 0), (0, 0)))[:, :, :, :nb]
        return jnp.concatenate([prev, tb], axis=4)

    qs = sub(q).reshape(b, h, dilation, nb, qb_sz, hd)
    kb = band(sub(k))
    vb = band(sub(v))
    qpos = jnp.arange(nb)[:, None] * qb_sz + jnp.arange(qb_sz)[None, :]
    kpos = jnp.arange(nb)[:, None] * qb_sz - qb_sz + jnp.arange(2 * qb_sz)[None, :]
    dist = qpos[:, :, None] - kpos[:, None, :]
    mask = (dist >= 0) & (dist <= wd) & (kpos[:, None, :] >= 0)
    sc = jnp.einsum('bhrnqd,bhrnkd->bhrnqk', qs, kb).astype(F32) * (hd ** -0.5)
    sc = jnp.where(mask, sc, -jnp.inf)
    m = jnp.max(sc, -1)
    p = jnp.exp(sc - m[..., None])
    l = jnp.sum(p, -1)
    o = jnp.einsum('bhrnqk,bhrnkd->bhrnqd', p, vb.astype(F32)) / l[..., None]

    def unsub(t):
        tail = t.shape[5:]
        t = t.reshape(b, h, dilation, lp, *tail)[:, :, :, :L]
        t = jnp.moveaxis(t, 2, 3)
        return t.reshape(b, h, s, *tail)

    return unsub(o), unsub(m), unsub(l)


def _dilated_attention(q, k, v):
    outs = [_dilated_branch(q, k, v, w, r) for (w, r) in DIL_PAIRS]
    m_all = jnp.stack([m for (_, m, _) in outs])
    m_max = jnp.max(m_all, 0)
    wts = jnp.stack([l * jnp.exp(m - m_max) for (_, m, l) in outs])
    o_all = jnp.stack([o for (o, _, _) in outs])
    return jnp.sum(wts[..., None] * o_all, 0) / jnp.sum(wts, 0)[..., None]


def _even_mixer(x, positions, w_in, w_out):
    hproj = x @ w_in
    sizes = (RET_QK_W, RET_QK_W, RET_V_W, RET_V_W, DIL_W, DIL_W, DIL_W)
    offs = [0]
    for sz in sizes:
        offs.append(offs[-1] + sz)
    qa, ka, va, ga, qb, kb, vb = [hproj[..., offs[i]:offs[i + 1]] for i in range(len(sizes))]
    qa = _rotary(_heads(qa, RET_HEADS), positions, RET_DK, RET_THETA).astype(F32)
    ka = _rotary(_heads(ka, RET_HEADS), positions, RET_DK, RET_THETA).astype(F32) * (RET_DK ** -0.5)
    ya = _rms(_retention(qa, ka, _heads(va, RET_HEADS).astype(F32)))
    ya = (_merge(ya) * jax.nn.silu(ga.astype(F32))).astype(x.dtype)
    qb = _rotary(_heads(qb, DIL_HEADS), positions, ROPE_DIMS, ROPE_THETA)
    kb = _rotary(_heads(kb, DIL_HEADS), positions, ROPE_DIMS, ROPE_THETA)
    yb = _merge(_dilated_attention(qb, kb, _heads(vb, DIL_HEADS))).astype(x.dtype)
    return jnp.concatenate([ya, yb], -1) @ w_out


def _gated_delta_rule(q, k, v, beta, g):
    b, h, s, dk = q.shape
    dv = v.shape[-1]
    c = GDN_CHUNK
    n = s // c
    ch = lambda t: t.reshape(b, h, n, c, *t.shape[3:])
    q, k, v, beta, g = ch(q), ch(k), ch(v), ch(beta), ch(g)
    gc = jnp.cumsum(g, -1)
    tri = jnp.tril(jnp.ones((c, c), bool))
    strict = jnp.tril(jnp.ones((c, c), bool), -1)
    diff = gc[..., :, None] - gc[..., None, :]
    decay = jnp.where(tri, jnp.exp(jnp.where(tri, diff, 0.0)), 0.0)
    kb = k * beta[..., None]
    a_mat = jnp.eye(c, dtype=F32) + jnp.where(strict, jnp.einsum('bhnid,bhnjd->bhnij', kb, k) * decay, 0.0)
    rhs = jnp.concatenate([v * beta[..., None], kb * jnp.exp(gc)[..., None]], -1)
    sol = lax.linalg.triangular_solve(a_mat, rhs, left_side=True, lower=True, unit_diagonal=True)
    u, w = sol[..., :dv], sol[..., dv:]
    attn = jnp.where(tri, jnp.einsum('bhnid,bhnjd->bhnij', q, k) * decay, 0.0)
    glast = gc[..., -1]
    k_dec = k * jnp.exp(glast[..., None] - gc)[..., None]
    q_dec = q * jnp.exp(gc)[..., None]

    def step(state, inp):
        qd_n, u_n, w_n, attn_n, kd_n, gl_n = inp
        v_new = u_n - jnp.einsum('bhcd,bhde->bhce', w_n, state)
        o_n = jnp.einsum('bhcd,bhde->bhce', qd_n, state) + jnp.einsum('bhij,bhje->bhie', attn_n, v_new)
        state = state * jnp.exp(gl_n)[..., None, None] + jnp.einsum('bhcd,bhce->bhde', kd_n, v_new)
        return state, o_n

    xs = tuple(jnp.moveaxis(t, 2, 0) for t in (q_dec, u, w, attn, k_dec, glast))
    _, o = lax.scan(step, jnp.zeros((b, h, dk, dv), F32), xs)
    return jnp.moveaxis(o, 0, 2).reshape(b, h, s, dv)


def _odd_mixer(x, w_in, conv_w, a_log, dt_bias, norm_w, w_out):
    hproj = x @ w_in
    qkv = jax.nn.silu(_causal_dwconv(hproj[..., :3 * GDN_W], conv_w))
    gate = hproj[..., 3 * GDN_W:4 * GDN_W]
    b_raw = hproj[..., 4 * GDN_W:4 * GDN_W + GDN_HEADS].astype(F32)
    a_raw = hproj[..., 4 * GDN_W + GDN_HEADS:].astype(F32)
    q = _l2norm(_heads(qkv[..., :GDN_W], GDN_HEADS).astype(F32)) * (GDN_DK ** -0.5)
    k = _l2norm(_heads(qkv[..., GDN_W:2 * GDN_W], GDN_HEADS).astype(F32))
    v = _heads(qkv[..., 2 * GDN_W:], GDN_HEADS).astype(F32)
    beta = jax.nn.sigmoid(b_raw).transpose(0, 2, 1)
    g = (-jnp.exp(a_log.astype(F32)) * jax.nn.softplus(a_raw + dt_bias.astype(F32))).transpose(0, 2, 1)
    o = _rms(_gated_delta_rule(q, k, v, beta, g)) * norm_w.astype(F32)
    o = (_merge(o) * jax.nn.silu(gate.astype(F32))).astype(x.dtype)
    return o @ w_out


def _conv_ffn(x, w_up, conv_w, conv_b, w_down):
    hproj = _causal_dwconv(x @ w_up, conv_w) + conv_b
    gate, val = hproj[..., :D_FF], hproj[..., D_FF:]
    return (jax.nn.silu(gate) * val) @ w_down


def setup_inputs(seed: int = 0) -> dict:
    key = jax.random.key(seed)
    ks = jax.random.split(key, 20)
    nrm = lambda kk, shape, scale: jax.random.normal(kk, shape, F32) * scale
    x = nrm(ks[0], (BATCH, SEQ, D_MODEL), 1.0)
    start = jax.random.randint(ks[1], (BATCH, 1), 0, 4096, dtype=jnp.int32)
    positions = start + jnp.arange(SEQ, dtype=jnp.int32)[None, :]
    ev_w_in = nrm(ks[2], (N_EVEN, D_MODEL, EV_IN), D_MODEL ** -0.5)
    ev_w_out = nrm(ks[3], (N_EVEN, EV_MIX, D_MODEL), EV_MIX ** -0.5 * DN_BETA)
    od_w_in = nrm(ks[4], (N_ODD, D_MODEL, OD_IN), D_MODEL ** -0.5)
    od_conv_w = nrm(ks[5], (N_ODD, GDN_CONV, 3 * GDN_W), GDN_CONV ** -0.5)
    od_a_log = jnp.log(jax.random.uniform(ks[6], (N_ODD, GDN_HEADS), F32, 1.0, 16.0))
    dt = jnp.exp(jax.random.uniform(ks[7], (N_ODD, GDN_HEADS), F32, math.log(1e-3), math.log(1e-1)))
    od_dt_bias = dt + jnp.log(-jnp.expm1(-dt))
    od_norm_w = 1.0 + nrm(ks[8], (N_ODD, GDN_DV), 0.02)
    od_w_out = nrm(ks[9], (N_ODD, GDN_W, D_MODEL), GDN_W ** -0.5 * DN_BETA)
    ffn_w_up = nrm(ks[10], (DEPTH, D_MODEL, 2 * D_FF), D_MODEL ** -0.5)
    ffn_conv_w = nrm(ks[11], (DEPTH, FFN_CONV, 2 * D_FF), FFN_CONV ** -0.5)
    ffn_conv_b = nrm(ks[12], (DEPTH, 2 * D_FF), 0.01)
    ffn_w_down = nrm(ks[13], (DEPTH, D_FF, D_MODEL), D_FF ** -0.5 * DN_BETA)
    ln1_g = 1.0 + nrm(ks[14], (DEPTH, D_MODEL), 0.02)
    ln1_b = nrm(ks[15], (DEPTH, D_MODEL), 0.01)
    ln2_g = 1.0 + nrm(ks[16], (DEPTH, D_MODEL), 0.02)
    ln2_b = nrm(ks[17], (DEPTH, D_MODEL), 0.01)
    return {"x": x, "positions": positions, "ev_w_in": ev_w_in, "ev_w_out": ev_w_out,
            "od_w_in": od_w_in, "od_conv_w": od_conv_w, "od_a_log": od_a_log,
            "od_dt_bias": od_dt_bias, "od_norm_w": od_norm_w, "od_w_out": od_w_out,
            "ffn_w_up": ffn_w_up, "ffn_conv_w": ffn_conv_w, "ffn_conv_b": ffn_conv_b,
            "ffn_w_down": ffn_w_down, "ln1_g": ln1_g, "ln1_b": ln1_b,
            "ln2_g": ln2_g, "ln2_b": ln2_b}


def reference(x, positions, ev_w_in, ev_w_out, od_w_in, od_conv_w, od_a_log, od_dt_bias,
              od_norm_w, od_w_out, ffn_w_up, ffn_conv_w, ffn_conv_b, ffn_w_down,
              ln1_g, ln1_b, ln2_g, ln2_b):
    for layer in range(DEPTH):
        j = layer // 2
        if layer % 2 == 0:
            mix = _even_mixer(x, positions, ev_w_in[j], ev_w_out[j])
        else:
            mix = _odd_mixer(x, od_w_in[j], od_conv_w[j], od_a_log[j], od_dt_bias[j],
                             od_norm_w[j], od_w_out[j])
        x = _layernorm(DN_ALPHA * x + mix, ln1_g[layer], ln1_b[layer])
        ffn = _conv_ffn(x, ffn_w_up[layer], ffn_conv_w[layer], ffn_conv_b[layer], ffn_w_down[layer])
        x = _layernorm(DN_ALPHA * x + ffn, ln2_g[layer], ln2_b[layer])
    return x
```

```cpp
#include <hip/hip_runtime.h>
#include <hip/hip_cooperative_groups.h>
#include <cstdio>
namespace cg = cooperative_groups;
namespace pg8 {
#define PG8_LAS __attribute__((address_space(3)))
typedef unsigned short bf16_t;
typedef short bf16x8 __attribute__((ext_vector_type(8)));
typedef float f32x4 __attribute__((ext_vector_type(4)));
typedef unsigned u32x4 __attribute__((ext_vector_type(4)));
constexpr int BM = 256, BK = 64, HALF = 128, HTB = HALF * BK * 2  , STAGE_BYTES = 8 * HTB, NXCD = 8, WGM = 8;

__host__ __device__ __forceinline__ int lds_byte(int r, int c) { const int st = (r >> 4) * 2 + (c >> 5), rr = r & 15, cc = c & 31, ob = rr * 64 + cc * 2; return st * 1024 + (ob ^ (((ob >> 9) & 1) << 5)); }
__host__ __device__ __forceinline__ void stage_rc(int b, int& R, int& C) { const int st = b / 1024, sb = b % 1024, swz = sb ^ (((sb >> 9) & 1) << 5); R = (st >> 1) * 16 + swz / 64; C = (st & 1) * 32 + (swz % 64) / 2; }
__host__ __device__ __forceinline__ int perm32(int rho) { const int n = rho >> 4, i = rho & 15; return 8 * (i >> 2) + 4 * n + (i & 3); }

struct Unit { int pm, pn; };
struct Gemm { const bf16_t* A; const bf16_t* Bt; int M, N, K; };

struct StaticOrder {
    int nM, nN, nwg, G, c;
    __host__ __device__ void init(int M, int N, int G_, int c_) { nM = M / BM; nN = N / BM; nwg = nM * nN; G = G_; c = c_; }
    __host__ __device__ bool next(int i, Unit& u) const {
        const long L = (long)i * G + c; if (L >= nwg) return false;
        int wgid = (int)L; { const int q = nwg / NXCD, r = nwg % NXCD, xcd = wgid % NXCD, off = wgid / NXCD; wgid = (xcd < r ? xcd * (q + 1) : r * (q + 1) + (xcd - r) * q) + off; }
        const int nig = WGM * nN, gid = wgid / nig, fm = gid * WGM, gsz = (nM - fm) < WGM ? (nM - fm) : WGM;
        u.pm = fm + ((wgid % nig) % gsz); u.pn = (wgid % nig) / gsz; return true;
    }
    __device__ __forceinline__ void a_ready(const Unit&) const {}
    __device__ __forceinline__ void done(const Unit&) const {}
};
__device__ __forceinline__ unsigned cvt_pk_bf16(float lo, float hi) { unsigned r; asm volatile("v_cvt_pk_bf16_f32 %0, %1, %2" : "=v"(r) : "v"(lo), "v"(hi)); return r; }

template <class Epi, class Sched, bool STAMP = false>
__device__ __forceinline__ void gemm_phase(PG8_LAS unsigned char* lds, const Gemm g, const Sched& S, const Epi& E, unsigned long long* stamps) {
    int tid_ = threadIdx.x; asm volatile("" : "+v"(tid_));
    const int tid = tid_, wid = __builtin_amdgcn_readfirstlane(tid >> 6), lane = tid & 63, wr = wid >> 2, wc = wid & 3, fr = lane & 15, fq = lane >> 4;
    const int K = g.K, nt = K / BK;
    int ts_lo = 0, ts_hi = 0, nts = 0; const unsigned long long rt_entry = STAMP ? (unsigned long long)wall_clock64() : 0ull;
#define PG8_STAMP() do { if (STAMP && wid == 0 && nts < 64) { const unsigned long long _c = (unsigned long long)clock64(); \
        ts_lo = (lane == nts) ? (int)(unsigned)_c : ts_lo; ts_hi = (lane == nts) ? (int)(unsigned)(_c >> 32) : ts_hi; ++nts; } } while (0)
    PG8_STAMP();
    unsigned voffA[2], voffB[2];
#pragma unroll
    for (int i = 0; i < 2; ++i) { int R, C; stage_rc(tid * 16 + i * 8192, R, C); const int Rb = Epi::PERM ? ((R & ~31) + perm32(R & 31)) : R;
        voffA[i] = (unsigned)(R * K + C) * 2u; voffB[i] = (unsigned)(Rb * K + C) * 2u; }
    const size_t kstep = (size_t)(BK * 2);
    const size_t hstep = (size_t)HALF * K * 2;
    const size_t tstep = 2 * hstep;
    const unsigned ldsw = (unsigned)wid * 1024u;
    const int aoff = lds_byte(wr * 64 + fr, fq * 8), boff = lds_byte(wc * 32 + fr, fq * 8);
#define PG8_SA(b, h) (((b) * 2 + (h)) * HTB)
#define PG8_SB(b, h) ((4 + (b) * 2 + (h)) * HTB)
#define PG8_STAGE(bufoff, gbase, voff) do { _Pragma("unroll") for (int _i = 0; _i < 2; ++_i) \
        __builtin_amdgcn_global_load_lds((const unsigned*)((const char*)(gbase) + (voff)[_i]), (PG8_LAS unsigned*)(lds + (bufoff) + ldsw + _i * 8192), 16, 0, 0); } while (0)
#define PG8_LDA(dst, b, h) do { _Pragma("unroll") for (int m = 0; m < 4; ++m) _Pragma("unroll") for (int k = 0; k < 2; ++k) dst[m][k] = *(const PG8_LAS bf16x8*)(lds + PG8_SA(b, h) + aoff + m * 2048 + k * 1024); } while (0)
#define PG8_LDB(dst, b, h) do { _Pragma("unroll") for (int n = 0; n < 2; ++n) _Pragma("unroll") for (int k = 0; k < 2; ++k) dst[n][k] = *(const PG8_LAS bf16x8*)(lds + PG8_SB(b, h) + boff + n * 2048 + k * 1024); } while (0)
#define PG8_MMA(ai, bj, At, Bt) do { __builtin_amdgcn_s_setprio(1); _Pragma("unroll") for (int m = 0; m < 4; ++m) _Pragma("unroll") for (int n = 0; n < 2; ++n) _Pragma("unroll") for (int k = 0; k < 2; ++k) \
        acc[ai][bj][m][n] = __builtin_amdgcn_mfma_f32_16x16x32_bf16(Bt[n][k], At[m][k], acc[ai][bj][m][n], 0, 0, 0); __builtin_amdgcn_s_setprio(0); } while (0)
#define PG8_WAIT_V(n) asm volatile("s_waitcnt vmcnt(" #n ")" ::: "memory")
#define PG8_WAIT_L(n) asm volatile("s_waitcnt lgkmcnt(" #n ")" ::: "memory")
#define PG8_BAR __builtin_amdgcn_s_barrier()
#define PG8_SCHED __builtin_amdgcn_sched_barrier(0)
    Unit cur, nxt; int ui = 0;
    if (!S.next(0, cur)) return;
    f32x4 acc[2][2][4][2];
#pragma unroll
    for (int a = 0; a < 2; ++a)
#pragma unroll
        for (int b = 0; b < 2; ++b)
#pragma unroll
            for (int m = 0; m < 4; ++m)
#pragma unroll
                for (int n = 0; n < 2; ++n) acc[a][b][m][n] = (f32x4){0.f, 0.f, 0.f, 0.f};
    bf16x8 At[4][2], B0[2][2], B1[2][2];
    const char* cA = (const char*)g.A + (size_t)cur.pm * tstep; const char* cB = (const char*)g.Bt + (size_t)cur.pn * tstep;
    S.a_ready(cur);
    PG8_STAGE(PG8_SB(0, 0), cB, voffB); PG8_STAGE(PG8_SA(0, 0), cA, voffA); PG8_STAGE(PG8_SB(0, 1), cB + hstep, voffB); PG8_STAGE(PG8_SA(0, 1), cA + hstep, voffA);
    if (wr == 1) PG8_BAR;
    PG8_WAIT_V(4); PG8_BAR;
    PG8_STAGE(PG8_SB(1, 0), cB + kstep, voffB); PG8_STAGE(PG8_SA(1, 0), cA + kstep, voffA); PG8_STAGE(PG8_SB(1, 1), cB + hstep + kstep, voffB);
    PG8_WAIT_V(6); PG8_BAR;
    PG8_STAMP();
    for (;;) {
        const bool has_next = S.next(ui + 1, nxt);
        const char* nA = has_next ? (const char*)g.A + (size_t)nxt.pm * tstep : cA; const char* nB = has_next ? (const char*)g.Bt + (size_t)nxt.pn * tstep : cB;
        for (int t = 0; t < nt; t += 2) {
            const bool last = (t == nt - 2);
            const char* a1 = cA + (size_t)(t + 1) * kstep;
            const char* a2 = last ? nA : cA + (size_t)(t + 2) * kstep; const char* b2 = last ? nB : cB + (size_t)(t + 2) * kstep;
            const char* a3 = a2 + kstep; const char* b3 = b2 + kstep;
            if (last && has_next) S.a_ready(nxt);
            PG8_LDB(B0, 0, 0); PG8_SCHED; PG8_LDA(At, 0, 0); PG8_STAGE(PG8_SA(1, 1), a1 + hstep, voffA);
            PG8_WAIT_L(8); PG8_BAR; PG8_WAIT_L(0); PG8_MMA(0, 0, At, B0); PG8_BAR; PG8_SCHED;
            PG8_LDB(B1, 0, 1); PG8_STAGE(PG8_SB(0, 0), b2, voffB);
            PG8_BAR; PG8_WAIT_L(0); PG8_MMA(0, 1, At, B1); PG8_BAR;
            PG8_LDA(At, 0, 1); PG8_STAGE(PG8_SA(0, 0), a2, voffA);
            PG8_BAR; PG8_WAIT_L(0); PG8_MMA(1, 0, At, B0); PG8_BAR; PG8_SCHED;
            PG8_STAGE(PG8_SB(0, 1), b2 + hstep, voffB);
            PG8_WAIT_V(6); PG8_BAR; PG8_MMA(1, 1, At, B1); PG8_BAR;
            PG8_LDB(B0, 1, 0); PG8_SCHED; PG8_LDA(At, 1, 0); PG8_STAGE(PG8_SA(0, 1), a2 + hstep, voffA);
            PG8_WAIT_L(8); PG8_BAR; PG8_WAIT_L(0); PG8_MMA(0, 0, At, B0); PG8_BAR; PG8_SCHED;
            PG8_LDB(B1, 1, 1); PG8_STAGE(PG8_SB(1, 0), b3, voffB);
            PG8_BAR; PG8_WAIT_L(0); PG8_MMA(0, 1, At, B1); PG8_BAR;
            PG8_LDA(At, 1, 1); PG8_STAGE(PG8_SA(1, 0), a3, voffA);
            PG8_BAR; PG8_WAIT_L(0); PG8_MMA(1, 0, At, B0); PG8_BAR; PG8_SCHED;
            PG8_STAGE(PG8_SB(1, 1), b3 + hstep, voffB);
            PG8_WAIT_V(6); PG8_BAR; PG8_MMA(1, 1, At, B1); PG8_BAR;
        }
        PG8_STAMP();
        if constexpr (!Epi::AFTER_DRAIN) { E(acc, cur, wr, wc, fr, fq); S.done(cur); }
        PG8_STAMP();
        if (!has_next) break;
#pragma unroll
        for (int a = 0; a < 2; ++a)
#pragma unroll
            for (int b = 0; b < 2; ++b)
#pragma unroll
                for (int m = 0; m < 4; ++m)
#pragma unroll
                    for (int n = 0; n < 2; ++n) acc[a][b][m][n] = (f32x4){0.f, 0.f, 0.f, 0.f};
        cur = nxt; cA = nA; cB = nB; ++ui;
    }
    PG8_WAIT_V(0);
    if (wr == 0) PG8_BAR;
    PG8_BAR;
    if constexpr (Epi::AFTER_DRAIN) { E.fused(acc, cur, wr, wc, fr, fq, lds, wid, lane); S.done(cur); }
    PG8_STAMP();
    if (STAMP && wid == 0) { stamps[lane] = lane < nts ? (((unsigned long long)(unsigned)ts_hi << 32) | (unsigned)ts_lo) : 0ull;
        if (lane == 62) stamps[62] = rt_entry; if (lane == 63) stamps[63] = (unsigned long long)wall_clock64(); }
#undef PG8_STAMP
#undef PG8_SA
#undef PG8_SB
#undef PG8_STAGE
#undef PG8_LDA
#undef PG8_LDB
#undef PG8_MMA
#undef PG8_WAIT_V
#undef PG8_WAIT_L
#undef PG8_BAR
#undef PG8_SCHED
}
}

#define LAS __attribute__((address_space(3)))
using pg8::bf16_t; using pg8::bf16x8; using pg8::f32x4; using pg8::u32x4;
typedef unsigned u32x2 __attribute__((ext_vector_type(2)));

constexpr int T = 16384, SEQ = 2048, DM = 1024;
constexpr int EVW = 4608, ODW = 4096, ODLD = 4112, FF2 = 5632, FF = 2816;
constexpr float DN_ALPHA = 1.681792830507429f;
constexpr float LN_EPS = 1e-5f;
constexpr size_t MiB = 1u << 20;
constexpr size_t WS_EG = 65536;
constexpr size_t WS_WMIN = 1 * MiB, WS_WMOUT = 10 * MiB, WS_WUP = 13 * MiB, WS_WDN = 24 * MiB;
constexpr size_t WS_XB = 30 * MiB, WS_COSA = 62 * MiB, WS_SINA = 66 * MiB, WS_COSB = 70 * MiB, WS_SINB = 70 * MiB + 512 * 1024, WS_AB = 71 * MiB;
constexpr size_t WS_BIG = 72 * MiB, WS_NEED = 352 * MiB;
constexpr size_t WS_HU = WS_BIG, WS_G = WS_BIG + 176 * MiB;
constexpr size_t WS_HP = WS_BIG, WS_MIXE = WS_BIG + 144 * MiB, WS_KVT = WS_BIG + 192 * MiB, WS_OG = WS_BIG + 224 * MiB, WS_MLM = WS_BIG + 272 * MiB, WS_MLL = WS_MLM + 1536 * 1024;
constexpr size_t WS_U = WS_BIG + 128 * MiB, WS_WM = WS_BIG + 160 * MiB, WS_QD = WS_BIG + 192 * MiB, WS_KDT = WS_BIG + 224 * MiB, WS_ATT = WS_BIG + 256 * MiB;
constexpr int LDS_BYTES = 147456;

struct P {
    const float* x; const int* pos; const float *ev_w_in, *ev_w_out, *od_w_in, *od_conv_w, *od_a_log, *od_dt_bias, *od_norm_w, *od_w_out,
        *ffn_w_up, *ffn_conv_w, *ffn_conv_b, *ffn_w_down, *ln1_g, *ln1_b, *ln2_g, *ln2_b;
    float* out; unsigned char* ws;
};
struct Ctx { LAS unsigned char* lds; int tid, lane, wave, q, r16, gw, ngw, gtid, nthr, bx, gx; };

__device__ __forceinline__ unsigned f2bf(float f) { unsigned u = __builtin_bit_cast(unsigned, f); return (u + 0x7fffu + ((u >> 16) & 1u)) >> 16; }
__device__ __forceinline__ unsigned pk2(float lo, float hi) { return f2bf(lo) | (f2bf(hi) << 16); }
__device__ __forceinline__ float bflo(unsigned w) { return __builtin_bit_cast(float, w << 16); }
__device__ __forceinline__ float bfhi(unsigned w) { return __builtin_bit_cast(float, w & 0xffff0000u); }
__device__ __forceinline__ float bf1(bf16_t b) { return __builtin_bit_cast(float, ((unsigned)b) << 16); }
#define UNPACK8(W_, F_) do { const u32x4 w_ = (W_); F_[0] = bflo(w_[0]); F_[1] = bfhi(w_[0]); F_[2] = bflo(w_[1]); F_[3] = bfhi(w_[1]); F_[4] = bflo(w_[2]); F_[5] = bfhi(w_[2]); F_[6] = bflo(w_[3]); F_[7] = bfhi(w_[3]); } while (0)
#define PACK8(F_) (u32x4){pk2(F_[0], F_[1]), pk2(F_[2], F_[3]), pk2(F_[4], F_[5]), pk2(F_[6], F_[7])}
__device__ __forceinline__ f32x4 mma(bf16x8 a, bf16x8 b, f32x4 c) { return __builtin_amdgcn_mfma_f32_16x16x32_bf16(a, b, c, 0, 0, 0); }
__device__ __forceinline__ float wave_sum(float v) {
#pragma unroll
    for (int o = 1; o < 64; o <<= 1) v += __shfl_xor(v, o);
    return v;
}
__device__ __forceinline__ float sum16(float v) { v += __shfl_xor(v, 1); v += __shfl_xor(v, 2); v += __shfl_xor(v, 4); v += __shfl_xor(v, 8); return v; }
__device__ __forceinline__ float max16(float v) { v = fmaxf(v, __shfl_xor(v, 1)); v = fmaxf(v, __shfl_xor(v, 2)); v = fmaxf(v, __shfl_xor(v, 4)); v = fmaxf(v, __shfl_xor(v, 8)); return v; }
__device__ __forceinline__ float silu_f(float x) { return x / (1.0f + __expf(-x)); }
#define LDS_WAIT() asm volatile("s_waitcnt lgkmcnt(0)" ::: "memory")

struct EpiStore {
    static constexpr bool PERM = true, AFTER_DRAIN = false;
    bf16_t* O; int ldc;
    __device__ __forceinline__ void operator()(const f32x4 (&acc)[2][2][4][2], const pg8::Unit& u, int wr, int wc, int fr, int fq) const {
        const int row0 = u.pm * 256 + wr * 64 + fr, col0 = u.pn * 256 + wc * 32 + 8 * fq;
#pragma unroll
        for (int ai = 0; ai < 2; ++ai)
#pragma unroll
            for (int m = 0; m < 4; ++m) { bf16_t* rowp = O + (size_t)(row0 + ai * 128 + m * 16) * ldc + col0;
#pragma unroll
                for (int bj = 0; bj < 2; ++bj) { const f32x4 v0 = acc[ai][bj][m][0], v1 = acc[ai][bj][m][1];
                    u32x4 w; w.x = pk2(v0[0], v0[1]); w.y = pk2(v0[2], v0[3]); w.z = pk2(v1[0], v1[1]); w.w = pk2(v1[2], v1[3]);
                    *(u32x4*)(rowp + bj * 128) = w; } }
    }
};
struct EpiResid {
    static constexpr bool PERM = false, AFTER_DRAIN = false;
    float* X;
    __device__ __forceinline__ void operator()(const f32x4 (&acc)[2][2][4][2], const pg8::Unit& u, int wr, int wc, int fr, int fq) const {
        const int row0 = u.pm * 256 + wr * 64 + fr, col0 = u.pn * 256 + wc * 32 + 4 * fq;
#pragma unroll
        for (int ai = 0; ai < 2; ++ai)
#pragma unroll
            for (int m = 0; m < 4; ++m) { float* rowp = X + (size_t)(row0 + ai * 128 + m * 16) * DM + col0;
#pragma unroll
                for (int bj = 0; bj < 2; ++bj)
#pragma unroll
                    for (int n = 0; n < 2; ++n) { f32x4* pp = (f32x4*)(rowp + bj * 128 + n * 16); *pp = *pp * DN_ALPHA + acc[ai][bj][m][n]; } }
    }
};
template <class Epi> __device__ __forceinline__ void run_gemm(const Ctx& c, const bf16_t* A, const bf16_t* Bt, int N, int K, const Epi& E) {
    pg8::Gemm g{A, Bt, T, N, K}; pg8::StaticOrder S; S.init(T, N, c.gx, c.bx);
    pg8::gemm_phase<Epi, pg8::StaticOrder, false>((PG8_LAS unsigned char*)c.lds, g, S, E, nullptr);
}

__device__ __forceinline__ void transpose_item(const float* W, int K, int ldw, int N, bf16_t* WT, LAS float* scr, int item, int lane) {
    const int nblk = N / 32, kb = item / nblk, nb = item % nblk, k0 = 64 * kb, n0 = 32 * nb;
#pragma unroll 8
    for (int i = 0; i < 32; ++i) { const int kk = 2 * i + (lane >> 5); scr[kk * 33 + (lane & 31)] = W[(size_t)(k0 + kk) * ldw + n0 + (lane & 31)]; }
    LDS_WAIT();
    const int ch = lane & 7;
#pragma unroll
    for (int j = 0; j < 4; ++j) { const int n = (lane >> 3) + 8 * j; const LAS float* s = scr + (8 * ch) * 33 + n;
        u32x4 o; o.x = pk2(s[0 * 33], s[1 * 33]); o.y = pk2(s[2 * 33], s[3 * 33]); o.z = pk2(s[4 * 33], s[5 * 33]); o.w = pk2(s[6 * 33], s[7 * 33]);
        *(u32x4*)(WT + (size_t)(n0 + n) * K + k0 + 8 * ch) = o; }
    LDS_WAIT();
}
__device__ __forceinline__ void convert2(const Ctx& c, const float* W1, int K1, int ld1, int N1, bf16_t* WT1, const float* W2, int K2, int ld2, int N2, bf16_t* WT2) {
    LAS float* scr = (LAS float*)(c.lds + c.wave * 16384);
    const int I1 = (K1 / 64) * (N1 / 32), I2 = (K2 / 64) * (N2 / 32);
    for (int it = c.gw; it < I1 + I2; it += c.ngw) {
        if (it < I1) transpose_item(W1, K1, ld1, N1, WT1, scr, it, c.lane);
        else transpose_item(W2, K2, ld2, N2, WT2, scr, it - I1, c.lane);
    }
}
__device__ __forceinline__ void convert_mixer(const Ctx& c, const P& p, int layer) {
    const int j = layer >> 1; bf16_t* win = (bf16_t*)(p.ws + WS_WMIN); bf16_t* wout = (bf16_t*)(p.ws + WS_WMOUT);
    if ((layer & 1) == 0) convert2(c, p.ev_w_in + (size_t)j * DM * EVW, DM, EVW, EVW, win, p.ev_w_out + (size_t)j * 1536 * DM, 1536, DM, DM, wout);
    else convert2(c, p.od_w_in + (size_t)j * DM * ODLD, DM, ODLD, ODW, win, p.od_w_out + (size_t)j * DM * DM, DM, DM, DM, wout);
}
__device__ __forceinline__ void convert_ffn(const Ctx& c, const P& p, int layer) {
    convert2(c, p.ffn_w_up + (size_t)layer * DM * FF2, DM, FF2, FF2, (bf16_t*)(p.ws + WS_WUP), p.ffn_w_down + (size_t)layer * FF * DM, FF, DM, DM, (bf16_t*)(p.ws + WS_WDN));
}

__device__ __forceinline__ void ph_copy_x(const Ctx& c, const float* x, float* X, bf16_t* XB) {
    for (int m = c.gw; m < T; m += c.ngw) {
#pragma unroll
        for (int j = 0; j < 4; ++j) { const f32x4 v = ((const f32x4*)(x + (size_t)m * DM))[c.lane + 64 * j];
            ((f32x4*)(X + (size_t)m * DM))[c.lane + 64 * j] = v;
            ((u32x2*)(XB + (size_t)m * DM))[c.lane + 64 * j] = (u32x2){pk2(v[0], v[1]), pk2(v[2], v[3])}; }
    }
}
__device__ __forceinline__ void ph_ln(const Ctx& c, float* X, bf16_t* XB, const float* g, const float* b) {
    for (int m = c.gw; m < T; m += c.ngw) {
        f32x4* xr = (f32x4*)(X + (size_t)m * DM) + c.lane;
        f32x4 v[4]; float s = 0.f;
#pragma unroll
        for (int j = 0; j < 4; ++j) { v[j] = xr[64 * j]; s += (v[j][0] + v[j][1]) + (v[j][2] + v[j][3]); }
        const float mean = wave_sum(s) * (1.f / DM); float s2 = 0.f;
#pragma unroll
        for (int j = 0; j < 4; ++j) { v[j] = v[j] - mean; s2 += (v[j][0] * v[j][0] + v[j][1] * v[j][1]) + (v[j][2] * v[j][2] + v[j][3] * v[j][3]); }
        const float rstd = 1.f / sqrtf(wave_sum(s2) * (1.f / DM) + LN_EPS);
#pragma unroll
        for (int j = 0; j < 4; ++j) { const f32x4 gg = ((const f32x4*)g)[c.lane + 64 * j], bb = ((const f32x4*)b)[c.lane + 64 * j];
            const f32x4 y = v[j] * rstd * gg + bb; xr[64 * j] = y;
            ((u32x2*)(XB + (size_t)m * DM))[c.lane + 64 * j] = (u32x2){pk2(y[0], y[1]), pk2(y[2], y[3])}; }
    }
}
__device__ __forceinline__ void ph_rot_tables(const Ctx& c, const int* pos, float* cosA, float* sinA, float* cosB, float* sinB) {
    for (int idx = c.gtid; idx < T * 72; idx += c.nthr) {
        const int t = idx / 72, i = idx % 72; const float pf = (float)pos[t];
        float inv; if (i < 64) inv = exp2f(-(float)i * (2.0f / 128.0f) * 13.287712379549449f); else inv = exp2f(-(float)(i - 64) * (2.0f / 16.0f) * 18.931568569324174f);
        const float ang = pf * inv; const double rev = (double)ang * 0.15915494309189535; const float fr = (float)(rev - floor(rev));
        const float sn = __builtin_amdgcn_sinf(fr), cs = __builtin_amdgcn_cosf(fr);
        if (i < 64) { cosA[t * 64 + i] = cs; sinA[t * 64 + i] = sn; } else { cosB[t * 8 + i - 64] = cs; sinB[t * 8 + i - 64] = sn; }
    }
}
__device__ __forceinline__ void ph_convgate(const Ctx& c, const bf16_t* HU, bf16_t* G, const float* cw, const float* cb) {
    constexpr int RUN = 16, NCG = FF / 8;
    for (int it = c.gtid; it < (T / RUN) * NCG; it += c.nthr) {
        const int run = it / NCG, f0 = (it % NCG) * 8, t0 = run * RUN;
        float wg[3][8], wv[3][8], bg[8], bv[8], hg0[8], hg1[8], hv0[8], hv1[8];
#pragma unroll
        for (int j = 0; j < 3; ++j)
#pragma unroll
            for (int i = 0; i < 8; ++i) { wg[j][i] = cw[j * FF2 + f0 + i]; wv[j][i] = cw[j * FF2 + FF + f0 + i]; }
#pragma unroll
        for (int i = 0; i < 8; ++i) { bg[i] = cb[f0 + i]; bv[i] = cb[FF + f0 + i]; hg0[i] = hg1[i] = hv0[i] = hv1[i] = 0.f; }
        if ((t0 & (SEQ - 1)) != 0) {
            u32x4 a = *(const u32x4*)(HU + (size_t)(t0 - 2) * FF2 + f0), b = *(const u32x4*)(HU + (size_t)(t0 - 2) * FF2 + FF + f0); UNPACK8(a, hg0); UNPACK8(b, hv0);
            a = *(const u32x4*)(HU + (size_t)(t0 - 1) * FF2 + f0); b = *(const u32x4*)(HU + (size_t)(t0 - 1) * FF2 + FF + f0); UNPACK8(a, hg1); UNPACK8(b, hv1);
        }
#pragma unroll 2
        for (int tt = 0; tt < RUN; ++tt) {
            const size_t t = t0 + tt; float cg_[8], cv_[8], o[8];
            const u32x4 a = *(const u32x4*)(HU + t * FF2 + f0), b = *(const u32x4*)(HU + t * FF2 + FF + f0); UNPACK8(a, cg_); UNPACK8(b, cv_);
#pragma unroll
            for (int i = 0; i < 8; ++i) { const float yg = bg[i] + wg[0][i] * hg0[i] + wg[1][i] * hg1[i] + wg[2][i] * cg_[i]; const float yv = bv[i] + wv[0][i] * hv0[i] + wv[1][i] * hv1[i] + wv[2][i] * cv_[i];
                o[i] = silu_f(yg) * yv; hg0[i] = hg1[i]; hg1[i] = cg_[i]; hv0[i] = hv1[i]; hv1[i] = cv_[i]; }
            *(u32x4*)(G + t * FF + f0) = PACK8(o);
        }
    }
}

template <class R> __device__ __forceinline__ void stage_N(LAS bf16_t* dst, int dld, R src_row, int nrows, int ncols, int tid) {
    const int cpr = ncols >> 3, nch = nrows * cpr;
    for (int idx = tid; idx < nch; idx += 512) { const int r = idx / cpr, cc = idx % cpr; const bf16_t* s = src_row(r);
        u32x4 w = (u32x4){0u, 0u, 0u, 0u}; if (s) w = *(const u32x4*)(s + cc * 8);
        *(LAS u32x4*)(dst + r * dld + cc * 8) = w; }
}
template <class R, class F> __device__ __forceinline__ void stage_T(LAS bf16_t* dst, int dld, R src_row, int nrows, int ncols, int tid, F scale) {
    const int nch = nrows * (ncols >> 3);
    for (int idx = tid; idx < nch; idx += 512) { const int r = idx & (nrows - 1), cc = idx / nrows; const bf16_t* s = src_row(r);
        u32x4 w = (u32x4){0u, 0u, 0u, 0u}; if (s) w = *(const u32x4*)(s + cc * 8);
        float f[8]; UNPACK8(w, f); const float sc = scale(r);
#pragma unroll
        for (int i = 0; i < 8; ++i) dst[(cc * 8 + i) * dld + r] = (bf16_t)f2bf(f[i] * sc); }
}

__device__ __forceinline__ void rot8(bf16_t* p1, bf16_t* p2, const float* cs, const float* sn, float sc) {
    const u32x4 a = *(const u32x4*)p1, b = *(const u32x4*)p2; float x1[8], x2[8], o1[8], o2[8]; UNPACK8(a, x1); UNPACK8(b, x2);
#pragma unroll
    for (int i = 0; i < 8; ++i) { const float c_ = cs[i], s_ = sn[i]; o1[i] = (x1[i] * c_ - x2[i] * s_) * sc; o2[i] = (x2[i] * c_ + x1[i] * s_) * sc; }
    *(u32x4*)p1 = PACK8(o1); *(u32x4*)p2 = PACK8(o2);
}
__device__ __forceinline__ void ph_rotary(const Ctx& c, bf16_t* HP, const float* cosA, const float* sinA, const float* cosB, const float* sinB) {
    for (int idx = c.gtid; idx < T * 80; idx += c.nthr) {
        const int t = idx / 80, it = idx % 80; bf16_t* row = HP + (size_t)t * EVW;
        if (it < 64) { const int which = it >> 5, h = (it >> 3) & 3, ci = it & 7; bf16_t* p1 = row + which * 512 + h * 128 + ci * 8;
            rot8(p1, p1 + 64, cosA + t * 64 + ci * 8, sinA + t * 64 + ci * 8, which ? 0.08838834764831845f : 1.0f); }
        else if (it < 72) { const int h = it - 64; bf16_t* base = row + 3072 + h * 64; const float sc = 0.125f * 1.4426950408889634f;
            rot8(base, base + 8, cosB + t * 8, sinB + t * 8, sc);
#pragma unroll
            for (int ch = 2; ch < 8; ++ch) { const u32x4 a = *(const u32x4*)(base + ch * 8); float f[8]; UNPACK8(a, f);
#pragma unroll
                for (int i = 0; i < 8; ++i) f[i] *= sc;
                *(u32x4*)(base + ch * 8) = PACK8(f); } }
        else { const int h = it - 72; bf16_t* base = row + 3584 + h * 64; rot8(base, base + 8, cosB + t * 8, sinB + t * 8, 1.0f); }
    }
}

__device__ __forceinline__ float ret_lg2(int h) { return log2f(1.0f - exp2f(-5.0f - (float)h)); }
__device__ __forceinline__ void item_ret_kv(const Ctx& c, int item, const bf16_t* HP, bf16_t* KVT) {
    const int bh = item >> 4, b = bh >> 2, h = bh & 3, n = item & 15; const size_t t0 = (size_t)b * SEQ + 128 * n; const float lg2 = ret_lg2(h);
    LAS bf16_t* sKT = (LAS bf16_t*)c.lds; LAS bf16_t* sVT = (LAS bf16_t*)(c.lds + 34816);
    stage_T(sKT, 136, [&](int j) { return HP + (t0 + j) * EVW + 512 + h * 128; }, 128, 128, c.tid, [&](int j) { return exp2f((float)(127 - j) * lg2); });
    stage_T(sVT, 136, [&](int j) { return HP + (t0 + j) * EVW + 1024 + h * 256; }, 128, 256, c.tid, [&](int) { return 1.0f; });
    __syncthreads();
    f32x4 acc[16];
#pragma unroll
    for (int nt = 0; nt < 16; ++nt) acc[nt] = (f32x4){0.f, 0.f, 0.f, 0.f};
#pragma unroll
    for (int ks = 0; ks < 4; ++ks) { const bf16x8 a = *(const LAS bf16x8*)(sKT + (16 * c.wave + c.r16) * 136 + 32 * ks + 8 * c.q);
#pragma unroll
        for (int nt = 0; nt < 16; ++nt) { const bf16x8 bb = *(const LAS bf16x8*)(sVT + (16 * nt + c.r16) * 136 + 32 * ks + 8 * c.q); acc[nt] = mma(a, bb, acc[nt]); } }
#pragma unroll
    for (int nt = 0; nt < 16; ++nt) { const int e = 16 * nt + c.r16;
        *(u32x2*)(KVT + ((size_t)item * 256 + e) * 128 + 16 * c.wave + 4 * c.q) = (u32x2){pk2(acc[nt][0], acc[nt][1]), pk2(acc[nt][2], acc[nt][3])}; }
    __syncthreads();
}
__device__ __forceinline__ void ph_ret_scan(const Ctx& c, bf16_t* KVT) {
    for (int idx = c.gtid; idx < 32 * 4096; idx += c.nthr) {
        const int bh = idx >> 12, ch = idx & 4095, h = bh & 3; const float gch = exp2f(128.0f * ret_lg2(h));
        float st[8];
#pragma unroll
        for (int i = 0; i < 8; ++i) st[i] = 0.f;
        for (int n = 0; n < 16; ++n) { u32x4* ptr = (u32x4*)(KVT + (size_t)(bh * 16 + n) * 32768 + ch * 8); const u32x4 w = *ptr; float tmp[8]; UNPACK8(w, tmp);
            *ptr = PACK8(st);
#pragma unroll
            for (int i = 0; i < 8; ++i) st[i] = st[i] * gch + tmp[i]; }
    }
}
__device__ __forceinline__ void item_ret_out(const Ctx& c, int item, const bf16_t* HP, const bf16_t* RT, bf16_t* MIX) {
    const int bh = item >> 4, b = bh >> 2, h = bh & 3, n = item & 15; const size_t t0 = (size_t)b * SEQ + 128 * n; const float lg2 = ret_lg2(h);
    LAS bf16_t* sK = (LAS bf16_t*)c.lds; LAS bf16_t* sVT = (LAS bf16_t*)(c.lds + 34816); LAS bf16_t* sP = (LAS bf16_t*)(c.lds + 34816 + 69632) + c.wave * 16 * 136;
    stage_N(sK, 136, [&](int j) { return HP + (t0 + j) * EVW + 512 + h * 128; }, 128, 128, c.tid);
    stage_T(sVT, 136, [&](int j) { return HP + (t0 + j) * EVW + 1024 + h * 256; }, 128, 256, c.tid, [&](int) { return 1.0f; });
    bf16x8 aQ[4];
    { const bf16_t* qrow = HP + (t0 + 16 * c.wave + c.r16) * EVW + h * 128;
#pragma unroll
      for (int ks = 0; ks < 4; ++ks) aQ[ks] = *(const bf16x8*)(qrow + 32 * ks + 8 * c.q); }
    __syncthreads();
#pragma unroll
    for (int nt = 0; nt < 8; ++nt) {
        if (nt <= c.wave) { f32x4 s = (f32x4){0.f, 0.f, 0.f, 0.f};
#pragma unroll
            for (int ks = 0; ks < 4; ++ks) { const bf16x8 bb = *(const LAS bf16x8*)(sK + (16 * nt + c.r16) * 136 + 32 * ks + 8 * c.q); s = mma(aQ[ks], bb, s); }
#pragma unroll
            for (int jj = 0; jj < 4; ++jj) { const int i = 16 * c.wave + 4 * c.q + jj, j = 16 * nt + c.r16; const float pv = (i >= j) ? s[jj] * exp2f((float)(i - j) * lg2) : 0.f;
                sP[(4 * c.q + jj) * 136 + 16 * nt + c.r16] = (bf16_t)f2bf(pv); } }
        else if (nt == c.wave + 1) {
#pragma unroll
            for (int jj = 0; jj < 4; ++jj) sP[(4 * c.q + jj) * 136 + 16 * nt + c.r16] = (bf16_t)0; }
    }
    f32x4 acc[16];
#pragma unroll
    for (int nt = 0; nt < 16; ++nt) acc[nt] = (f32x4){0.f, 0.f, 0.f, 0.f};
    const bf16_t* rt = RT + (size_t)item * 32768;
#pragma unroll
    for (int ks = 0; ks < 4; ++ks)
#pragma unroll
        for (int nt = 0; nt < 16; ++nt) { const bf16x8 bb = *(const bf16x8*)(rt + (16 * nt + c.r16) * 128 + 32 * ks + 8 * c.q); acc[nt] = mma(aQ[ks], bb, acc[nt]); }
    {   float xi[4];
#pragma unroll
        for (int jj = 0; jj < 4; ++jj) xi[jj] = exp2f((float)(16 * c.wave + 4 * c.q + jj + 1) * lg2);
#pragma unroll
        for (int nt = 0; nt < 16; ++nt)
#pragma unroll
            for (int jj = 0; jj < 4; ++jj) acc[nt][jj] *= xi[jj]; }
    LDS_WAIT();
#pragma unroll
    for (int ks = 0; ks < 4; ++ks) {
        if (ks <= (c.wave >> 1)) { const bf16x8 a = *(const LAS bf16x8*)(sP + c.r16 * 136 + 32 * ks + 8 * c.q);
#pragma unroll
            for (int nt = 0; nt < 16; ++nt) { const bf16x8 bb = *(const LAS bf16x8*)(sVT + (16 * nt + c.r16) * 136 + 32 * ks + 8 * c.q); acc[nt] = mma(a, bb, acc[nt]); } }
    }
    float rstd[4];
#pragma unroll
    for (int jj = 0; jj < 4; ++jj) { float ss = 0.f;
#pragma unroll
        for (int nt = 0; nt < 16; ++nt) ss += acc[nt][jj] * acc[nt][jj];
        ss = sum16(ss); rstd[jj] = 1.f / sqrtf(ss * (1.f / 256.f) + LN_EPS); }
#pragma unroll
    for (int jj = 0; jj < 4; ++jj) { const size_t t = t0 + 16 * c.wave + 4 * c.q + jj;
#pragma unroll
        for (int nt = 0; nt < 16; ++nt) { const int e = 16 * nt + c.r16; const float gt = bf1(HP[t * EVW + 2048 + h * 256 + e]);
            MIX[t * 1536 + h * 256 + e] = (bf16_t)f2bf(acc[nt][jj] * rstd[jj] * silu_f(gt)); } }
    __syncthreads();
}

__device__ __forceinline__ void item_dil(const Ctx& c, int g, int ii, const bf16_t* HP, bf16_t* OG, float* MLm, float* MLl) {
    const int ld = 2 * g, d = 1 << ld;
    const int bh = ii >> 4, b = bh >> 3, h = bh & 7, rem = ii & 15, r = rem & (d - 1), j = rem >> ld;
    LAS bf16_t* sK = (LAS bf16_t*)c.lds; LAS bf16_t* sVT = (LAS bf16_t*)(c.lds + 36864); LAS bf16_t* sP = (LAS bf16_t*)(c.lds + 36864 + 35840) + c.wave * 16 * 168;
    const size_t tb = (size_t)b * SEQ;
    stage_N(sK, 72, [&](int kk) -> const bf16_t* { const int lk = 128 * (j - 1) + kk; return lk >= 0 ? HP + (tb + (size_t)lk * d + r) * EVW + 3584 + h * 64 : nullptr; }, 256, 64, c.tid);
    stage_T(sVT, 280, [&](int kk) -> const bf16_t* { const int lk = 128 * (j - 1) + kk; return lk >= 0 ? HP + (tb + (size_t)lk * d + r) * EVW + 4096 + h * 64 : nullptr; }, 256, 64, c.tid, [&](int) { return 1.0f; });
    for (int idx = c.tid; idx < 64 * 24; idx += 512) sVT[(idx / 24) * 280 + 256 + idx % 24] = (bf16_t)0;
    bf16x8 aQ[2];
    { const bf16_t* qrow = HP + (tb + (size_t)(128 * j + 16 * c.wave + c.r16) * d + r) * EVW + 3072 + h * 64;
      aQ[0] = *(const bf16x8*)(qrow + 8 * c.q); aQ[1] = *(const bf16x8*)(qrow + 32 + 8 * c.q); }
    *(LAS u32x2*)(sP + (c.lane >> 2) * 168 + 144 + 4 * (c.lane & 3)) = (u32x2){0u, 0u};
    __syncthreads();
    f32x4 s[9]; float mx[4] = {-INFINITY, -INFINITY, -INFINITY, -INFINITY};
#pragma unroll
    for (int tt = 0; tt < 9; ++tt) { const int kt = c.wave + tt; f32x4 a = (f32x4){0.f, 0.f, 0.f, 0.f};
#pragma unroll
        for (int ks = 0; ks < 2; ++ks) { const bf16x8 bb = *(const LAS bf16x8*)(sK + (16 * kt + c.r16) * 72 + 32 * ks + 8 * c.q); a = mma(aQ[ks], bb, a); }
#pragma unroll
        for (int jj = 0; jj < 4; ++jj) { const int i = 16 * c.wave + 4 * c.q + jj, kk = 16 * kt + c.r16, dist = 128 + i - kk;
            const bool ok = (dist >= 0) && (dist <= 128) && (j > 0 || kk >= 128);
            a[jj] = ok ? a[jj] : -INFINITY; mx[jj] = fmaxf(mx[jj], a[jj]); }
        s[tt] = a; }
    float l[4];
#pragma unroll
    for (int jj = 0; jj < 4; ++jj) { mx[jj] = max16(mx[jj]); l[jj] = 0.f; }
#pragma unroll
    for (int tt = 0; tt < 9; ++tt)
#pragma unroll
        for (int jj = 0; jj < 4; ++jj) { const float pv = exp2f(s[tt][jj] - mx[jj]); l[jj] += pv; sP[(4 * c.q + jj) * 168 + 16 * tt + c.r16] = (bf16_t)f2bf(pv); }
#pragma unroll
    for (int jj = 0; jj < 4; ++jj) l[jj] = sum16(l[jj]);
    LDS_WAIT();
    f32x4 o[4];
#pragma unroll
    for (int et = 0; et < 4; ++et) o[et] = (f32x4){0.f, 0.f, 0.f, 0.f};
#pragma unroll
    for (int ks = 0; ks < 5; ++ks) { const bf16x8 a = *(const LAS bf16x8*)(sP + c.r16 * 168 + 32 * ks + 8 * c.q);
#pragma unroll
        for (int et = 0; et < 4; ++et) { const bf16x8 bb = *(const LAS bf16x8*)(sVT + (16 * et + c.r16) * 280 + 16 * c.wave + 32 * ks + 8 * c.q); o[et] = mma(a, bb, o[et]); } }
#pragma unroll
    for (int jj = 0; jj < 4; ++jj) { const int i = 16 * c.wave + 4 * c.q + jj; const size_t tq = tb + (size_t)(128 * j + i) * d + r; const float inv = 1.f / l[jj];
#pragma unroll
        for (int et = 0; et < 4; ++et) OG[((size_t)g * T + tq) * 512 + h * 64 + 16 * et + c.r16] = (bf16_t)f2bf(o[et][jj] * inv);
        if (c.r16 == 0) { MLm[((size_t)g * T + tq) * 8 + h] = mx[jj]; MLl[((size_t)g * T + tq) * 8 + h] = l[jj]; } }
    __syncthreads();
}
__device__ __forceinline__ void ph_dil_combine(const Ctx& c, const bf16_t* OG, const float* MLm, const float* MLl, bf16_t* MIX) {
    for (int idx = c.gtid; idx < T * 64; idx += c.nthr) {
        const int t = idx >> 6, h = (idx >> 3) & 7, ch = idx & 7;
        float m[3], w[3];
#pragma unroll
        for (int g = 0; g < 3; ++g) { m[g] = MLm[((size_t)g * T + t) * 8 + h]; w[g] = MLl[((size_t)g * T + t) * 8 + h]; }
        const float mm = fmaxf(m[0], fmaxf(m[1], m[2])); float ws = 0.f;
#pragma unroll
        for (int g = 0; g < 3; ++g) { w[g] *= exp2f(m[g] - mm); ws += w[g]; }
        float acc[8];
#pragma unroll
        for (int i = 0; i < 8; ++i) acc[i] = 0.f;
#pragma unroll
        for (int g = 0; g < 3; ++g) { const u32x4 a = *(const u32x4*)(OG + ((size_t)g * T + t) * 512 + h * 64 + ch * 8); float f[8]; UNPACK8(a, f);
#pragma unroll
            for (int i = 0; i < 8; ++i) acc[i] += w[g] * f[i]; }
        const float inv = 1.f / ws;
#pragma unroll
        for (int i = 0; i < 8; ++i) acc[i] *= inv;
        *(u32x4*)(MIX + (size_t)t * 1536 + 1024 + h * 64 + ch * 8) = PACK8(acc);
    }
}

__device__ __forceinline__ void ph_ab(const Ctx& c, const float* X, const float* W  , float* AB) {
    for (int m = c.gw; m < T; m += c.ngw) {
        f32x4 a[4];
#pragma unroll
        for (int i = 0; i < 4; ++i) a[i] = (f32x4){0.f, 0.f, 0.f, 0.f};
#pragma unroll
        for (int j = 0; j < 4; ++j) { const f32x4 xv = ((const f32x4*)(X + (size_t)m * DM))[c.lane + 64 * j];
#pragma unroll
            for (int e = 0; e < 4; ++e) { const float* wr = W + (size_t)(4 * c.lane + 256 * j + e) * ODLD + ODW;
#pragma unroll
                for (int i = 0; i < 4; ++i) a[i] += ((const f32x4*)wr)[i] * xv[e]; } }
#pragma unroll
        for (int i = 0; i < 4; ++i)
#pragma unroll
            for (int e = 0; e < 4; ++e) a[i][e] = wave_sum(a[i][e]);
        if (c.lane == 0) {
#pragma unroll
            for (int i = 0; i < 4; ++i) ((f32x4*)(AB + (size_t)m * 16))[i] = a[i]; }
    }
}
__device__ __forceinline__ void item_gdn_chunk(const Ctx& c, int item, const bf16_t* HP, const float* AB, const float* convw, float alog, float dtb,
                                               bf16_t* U, bf16_t* WM, bf16_t* QD, bf16_t* KDT, bf16_t* ATT, float* EG) {
    const int bh = item >> 5, b = bh >> 3, h = bh & 7, n = item & 31; const size_t t0 = (size_t)b * SEQ + 64 * n;
    LAS bf16_t* sQ = (LAS bf16_t*)c.lds; LAS bf16_t* sK = (LAS bf16_t*)(c.lds + 17408); LAS bf16_t* sKD = (LAS bf16_t*)(c.lds + 34816);
    LAS float* sRHS = (LAS float*)(c.lds + 53248); LAS float* sA = (LAS float*)(c.lds + 119808); LAS float* sBeta = (LAS float*)(c.lds + 137216); LAS float* sGc = (LAS float*)(c.lds + 137472);
    if (c.wave == 0) {
        const float braw = AB[(t0 + c.lane) * 16 + h], araw = AB[(t0 + c.lane) * 16 + 8 + h] + dtb;
        const float beta = 1.f / (1.f + __expf(-braw));
        const float sp = fmaxf(araw, 0.f) + log1pf(__expf(-fabsf(araw)));
        float g = -__expf(alog) * sp;
#pragma unroll
        for (int off = 1; off < 64; off <<= 1) { const float v = __shfl_up(g, off); if (c.lane >= off) g += v; }
        sBeta[c.lane] = beta; sGc[c.lane] = g; if (c.lane == 63) EG[item] = __expf(g);
    }
    __syncthreads();
    const float glast = sGc[63];
#pragma unroll
    for (int which = 0; which < 3; ++which)
#pragma unroll
        for (int pass = 0; pass < 2; ++pass) {
            const int tok = 32 * pass + 4 * c.wave + c.q, col = which * 1024 + h * 128 + 8 * c.r16; const size_t t = t0 + tok; const int tin = (int)(t & (SEQ - 1));
            float y[8];
#pragma unroll
            for (int i = 0; i < 8; ++i) y[i] = 0.f;
#pragma unroll
            for (int jt = 0; jt < 4; ++jt) { if (tin - 3 + jt >= 0) { const u32x4 w = *(const u32x4*)(HP + (t - 3 + jt) * ODW + col); float f[8]; UNPACK8(w, f);
                const f32x4 c0 = *(const f32x4*)(convw + jt * 3072 + col), c1 = *(const f32x4*)(convw + jt * 3072 + col + 4);
#pragma unroll
                for (int i = 0; i < 4; ++i) { y[i] += c0[i] * f[i]; y[4 + i] += c1[i] * f[4 + i]; } } }
#pragma unroll
            for (int i = 0; i < 8; ++i) y[i] = silu_f(y[i]);
            const float gcv = sGc[tok], betav = sBeta[tok];
            if (which < 2) { float ss = 0.f;
#pragma unroll
                for (int i = 0; i < 8; ++i) ss += y[i] * y[i];
                ss = sum16(ss); const float rn = (1.f / sqrtf(ss + 1e-6f)) * (which == 0 ? 0.08838834764831845f : 1.0f);
#pragma unroll
                for (int i = 0; i < 8; ++i) y[i] *= rn; }
            if (which == 0) { *(LAS u32x4*)(sQ + tok * 136 + 8 * c.r16) = PACK8(y); const float eg = __expf(gcv); float z[8];
#pragma unroll
                for (int i = 0; i < 8; ++i) z[i] = y[i] * eg;
                *(u32x4*)(QD + t * DM + h * 128 + 8 * c.r16) = PACK8(z); }
            else if (which == 1) { *(LAS u32x4*)(sK + tok * 136 + 8 * c.r16) = PACK8(y); const float e1 = betav * __expf(gcv), e2 = __expf(glast - gcv);
#pragma unroll
                for (int i = 0; i < 8; ++i) { sRHS[tok * 260 + 128 + 8 * c.r16 + i] = y[i] * e1; sKD[(8 * c.r16 + i) * 72 + tok] = (bf16_t)f2bf(y[i] * e2); } }
            else {
#pragma unroll
                for (int i = 0; i < 8; ++i) sRHS[tok * 260 + 8 * c.r16 + i] = y[i] * betav; }
        }
    __syncthreads();
#pragma unroll
    for (int ts = 0; ts < 2; ++ts) { const int idx = 2 * c.wave + ts, mt = idx >> 2, nt = idx & 3; f32x4 aK = (f32x4){0.f, 0.f, 0.f, 0.f}, aQ = aK;
#pragma unroll
        for (int ks = 0; ks < 4; ++ks) { const bf16x8 ak = *(const LAS bf16x8*)(sK + (16 * mt + c.r16) * 136 + 32 * ks + 8 * c.q), aq = *(const LAS bf16x8*)(sQ + (16 * mt + c.r16) * 136 + 32 * ks + 8 * c.q),
                bb = *(const LAS bf16x8*)(sK + (16 * nt + c.r16) * 136 + 32 * ks + 8 * c.q); aK = mma(ak, bb, aK); aQ = mma(aq, bb, aQ); }
#pragma unroll
        for (int jj = 0; jj < 4; ++jj) { const int i = 16 * mt + 4 * c.q + jj, jx = 16 * nt + c.r16; const float dec = (i >= jx) ? __expf(sGc[i] - sGc[jx]) : 0.f;
            sA[i * 68 + jx] = (i > jx) ? sBeta[i] * aK[jj] * dec : 0.f;
            ATT[((size_t)item * 64 + i) * 64 + jx] = (bf16_t)f2bf(aQ[jj] * dec); } }
    for (int idx = c.tid; idx < 1024; idx += 512) { const int dd = idx >> 3, cc = idx & 7; *(u32x4*)(KDT + ((size_t)item * 128 + dd) * 64 + cc * 8) = *(const LAS u32x4*)(sKD + dd * 72 + cc * 8); }
    __syncthreads();
    if (c.tid < 256) { const int col = c.tid; float x[64]; LAS float* sAv = sA; asm volatile("" : "+v"(sAv)); LAS float* sRv = sRHS + col; asm volatile("" : "+v"(sRv));
        bf16_t* dst = (col < 128) ? U + t0 * DM + h * 128 + col : WM + t0 * DM + h * 128 + (col - 128);
#pragma unroll
        for (int i = 0; i < 64; ++i) x[i] = 0.f;
#pragma unroll
        for (int i = 0; i < 64; ++i) { float v = sRv[i * 260];
#pragma unroll
            for (int jc = 0; jc < (i + 3) / 4; ++jc) { const f32x4 a = *(volatile LAS f32x4*)(sAv + i * 68 + 4 * jc);
                v -= a[0] * x[4 * jc]; v -= a[1] * x[4 * jc + 1]; v -= a[2] * x[4 * jc + 2]; v -= a[3] * x[4 * jc + 3]; }
            x[i] = v; dst[(size_t)i * DM] = (bf16_t)f2bf(v); __builtin_amdgcn_sched_barrier(0); } }
    __syncthreads();
}
__device__ __forceinline__ void chain_gdn(const Ctx& c, int chain, bf16_t* U, const bf16_t* WM, const bf16_t* QD, const bf16_t* KDT, const bf16_t* ATT, const float* EG) {
    const int bh = chain >> 2, sl = chain & 3, b = bh >> 3, h = bh & 7; const int mt = c.wave & 3, nt = c.wave >> 2;
    LAS bf16_t* sSt = (LAS bf16_t*)c.lds; LAS bf16_t* sVT = (LAS bf16_t*)(c.lds + 8704);
    f32x4 accS[2]; accS[0] = (f32x4){0.f, 0.f, 0.f, 0.f}; accS[1] = accS[0];
    for (int idx = c.tid; idx < 32 * 136 / 2; idx += 512) ((LAS unsigned*)sSt)[idx] = 0u;
    __syncthreads();
    for (int n = 0; n < 32; ++n) {
        const int ci = bh * 32 + n; const size_t t0 = (size_t)b * SEQ + 64 * n;
        const size_t rowA = (t0 + 16 * mt + c.r16) * DM + h * 128 + 8 * c.q;
        bf16x8 aW[4], aQd[4], aAt[2], bKd[2];
#pragma unroll
        for (int ks = 0; ks < 4; ++ks) { aW[ks] = *(const bf16x8*)(WM + rowA + 32 * ks); aQd[ks] = *(const bf16x8*)(QD + rowA + 32 * ks); }
#pragma unroll
        for (int ks = 0; ks < 2; ++ks) { aAt[ks] = *(const bf16x8*)(ATT + ((size_t)ci * 64 + 16 * mt + c.r16) * 64 + 32 * ks + 8 * c.q);
            bKd[ks] = *(const bf16x8*)(KDT + ((size_t)ci * 128 + 16 * c.wave + c.r16) * 64 + 32 * ks + 8 * c.q); }
        bf16_t* up = U + (t0 + 16 * mt + 4 * c.q) * DM + h * 128 + 32 * sl + 16 * nt + c.r16;
        float u[4];
#pragma unroll
        for (int jj = 0; jj < 4; ++jj) u[jj] = bf1(up[(size_t)jj * DM]);
        const float eg = EG[ci];
        f32x4 av = (f32x4){0.f, 0.f, 0.f, 0.f}, ao = av;
#pragma unroll
        for (int ks = 0; ks < 4; ++ks) { const bf16x8 bS = *(const LAS bf16x8*)(sSt + (16 * nt + c.r16) * 136 + 32 * ks + 8 * c.q); av = mma(aW[ks], bS, av); ao = mma(aQd[ks], bS, ao); }
        *(LAS u32x2*)(sVT + (16 * nt + c.r16) * 72 + 16 * mt + 4 * c.q) = (u32x2){pk2(u[0] - av[0], u[1] - av[1]), pk2(u[2] - av[2], u[3] - av[3])};
        __syncthreads();
#pragma unroll
        for (int ks = 0; ks < 2; ++ks) { const bf16x8 bV = *(const LAS bf16x8*)(sVT + (16 * nt + c.r16) * 72 + 32 * ks + 8 * c.q); ao = mma(aAt[ks], bV, ao); }
#pragma unroll
        for (int jj = 0; jj < 4; ++jj) up[(size_t)jj * DM] = (bf16_t)f2bf(ao[jj]);
#pragma unroll
        for (int et = 0; et < 2; ++et) { accS[et] = accS[et] * eg;
#pragma unroll
            for (int ks = 0; ks < 2; ++ks) { const bf16x8 aV = *(const LAS bf16x8*)(sVT + (16 * et + c.r16) * 72 + 32 * ks + 8 * c.q); accS[et] = mma(aV, bKd[ks], accS[et]); }
#pragma unroll
            for (int jj = 0; jj < 4; ++jj) sSt[(16 * et + 4 * c.q + jj) * 136 + 16 * c.wave + c.r16] = (bf16_t)f2bf(accS[et][jj]); }
        __syncthreads();
    }
}
__device__ __forceinline__ void ph_gdn_out(const Ctx& c, const bf16_t* O, const bf16_t* HP, const float* normw, bf16_t* MIX) {
    for (int m = c.gw; m < T; m += c.ngw) {
        const u32x4 a0 = *(const u32x4*)(O + (size_t)m * DM + 16 * c.lane), a1 = *(const u32x4*)(O + (size_t)m * DM + 16 * c.lane + 8);
        const u32x4 g0 = *(const u32x4*)(HP + (size_t)m * ODW + 3072 + 16 * c.lane), g1 = *(const u32x4*)(HP + (size_t)m * ODW + 3072 + 16 * c.lane + 8);
        float o[16], gt[16]; UNPACK8(a0, o); { float* o8 = o + 8; UNPACK8(a1, o8); } UNPACK8(g0, gt); { float* g8 = gt + 8; UNPACK8(g1, g8); }
        float ss = 0.f;
#pragma unroll
        for (int i = 0; i < 16; ++i) ss += o[i] * o[i];
        ss += __shfl_xor(ss, 1); ss += __shfl_xor(ss, 2); ss += __shfl_xor(ss, 4);
        const float rstd = 1.f / sqrtf(ss * (1.f / 128.f) + LN_EPS);
        float y[16];
#pragma unroll
        for (int i = 0; i < 16; ++i) y[i] = o[i] * rstd * normw[((16 * c.lane) & 127) + i] * silu_f(gt[i]);
        *(u32x4*)(MIX + (size_t)m * DM + 16 * c.lane) = PACK8(y); { float* y8 = y + 8; *(u32x4*)(MIX + (size_t)m * DM + 16 * c.lane + 8) = PACK8(y8); }
    }
}

__device__ __forceinline__ Ctx mkctx(unsigned char* lds_raw) {
    int t = threadIdx.x; asm volatile("" : "+v"(t)); int bx = blockIdx.x; asm volatile("" : "+s"(bx)); int gx = gridDim.x; asm volatile("" : "+s"(gx));
    Ctx c; c.lds = (LAS unsigned char*)lds_raw; c.tid = t; c.lane = t & 63; c.wave = __builtin_amdgcn_readfirstlane(t >> 6); c.q = c.lane >> 4; c.r16 = c.lane & 15;
    c.gw = bx * 8 + c.wave; c.ngw = gx * 8; c.gtid = bx * 512 + t; c.nthr = gx * 512; c.bx = bx; c.gx = gx; return c;
}
__device__ __forceinline__ unsigned char* opaque_ptr(unsigned char* p) { asm volatile("" : "+s"(p)); return p; }
__global__ void __launch_bounds__(512, 2) fwd(P p) {
    extern __shared__ __attribute__((aligned(16))) unsigned char lds_raw[];
    cg::grid_group grid = cg::this_grid();
#define WSB(off) (opaque_ptr(p.ws) + (off))
#define X ((float*)opaque_ptr((unsigned char*)p.out))
#define XB ((bf16_t*)WSB(WS_XB))
#define WMIN ((bf16_t*)WSB(WS_WMIN))
#define WMOUT ((bf16_t*)WSB(WS_WMOUT))
#define WUP ((bf16_t*)WSB(WS_WUP))
#define WDN ((bf16_t*)WSB(WS_WDN))
#define cosA ((float*)WSB(WS_COSA))
#define sinA ((float*)WSB(WS_SINA))
#define cosB ((float*)WSB(WS_COSB))
#define sinB ((float*)WSB(WS_SINB))
#define AB ((float*)WSB(WS_AB))
#define HP ((bf16_t*)WSB(WS_HP))
#define HU ((bf16_t*)WSB(WS_HU))
#define G ((bf16_t*)WSB(WS_G))
#define MIXE ((bf16_t*)WSB(WS_MIXE))
#define KVT ((bf16_t*)WSB(WS_KVT))
#define OG ((bf16_t*)WSB(WS_OG))
#define MLm ((float*)WSB(WS_MLM))
#define MLl ((float*)WSB(WS_MLL))
#define U ((bf16_t*)WSB(WS_U))
#define WM ((bf16_t*)WSB(WS_WM))
#define QD ((bf16_t*)WSB(WS_QD))
#define KDT ((bf16_t*)WSB(WS_KDT))
#define ATT ((bf16_t*)WSB(WS_ATT))
#define EG ((float*)WSB(WS_EG))

#define CTX const Ctx c = mkctx(lds_raw)
    { CTX; convert_mixer(c, p, 0); }
    { CTX; convert_ffn(c, p, 0); }
    { CTX; ph_copy_x(c, p.x, X, XB); }
    { CTX; ph_rot_tables(c, p.pos, cosA, sinA, cosB, sinB); }
    grid.sync();

    for (int layer = 0; layer < 4; ++layer) {
        const int jl = layer >> 1; const bool even = (layer & 1) == 0;
        if (!even) { CTX; ph_ab(c, X, p.od_w_in + (size_t)jl * DM * ODLD, AB); }
        { CTX; const int N = even ? EVW : ODW; EpiStore E{HP, N}; run_gemm(c, XB, WMIN, N, DM, E); }
        grid.sync();
        if (even) {
            { CTX; ph_rotary(c, HP, cosA, sinA, cosB, sinB); }
            grid.sync();
            { CTX; for (int it = c.bx; it < 512 + 3072; it += c.gx) {
                if (it < 512) item_ret_kv(c, it, HP, KVT);
                else { const int d = it - 512; item_dil(c, d >> 10, d & 1023, HP, OG, MLm, MLl); } } }
            grid.sync();
            { CTX; ph_ret_scan(c, KVT); }
            { CTX; ph_dil_combine(c, OG, MLm, MLl, MIXE); }
            grid.sync();
            { CTX; for (int it = c.bx; it < 512; it += c.gx) item_ret_out(c, it, HP, KVT, MIXE); }
            grid.sync();
        } else {
            { CTX; for (int it = c.bx; it < 2048; it += c.gx) { const int h = (it >> 5) & 7;
                item_gdn_chunk(c, it, HP, AB, p.od_conv_w + (size_t)jl * 4 * 3072, p.od_a_log[jl * 8 + h], p.od_dt_bias[jl * 8 + h], U, WM, QD, KDT, ATT, EG); } }
            grid.sync();
            { CTX; for (int ch = c.bx; ch < 256; ch += c.gx) chain_gdn(c, ch, U, WM, QD, KDT, ATT, EG); }
            grid.sync();
            { CTX; ph_gdn_out(c, U, HP, p.od_norm_w + jl * 128, WM); }
            grid.sync();
        }
        { CTX; EpiResid E{X}; run_gemm(c, even ? MIXE : WM, WMOUT, DM, even ? 1536 : 1024, E); }
        grid.sync();
        { CTX; ph_ln(c, X, XB, p.ln1_g + layer * DM, p.ln1_b + layer * DM); }
        if (layer < 3) { CTX; convert_mixer(c, p, layer + 1); }
        grid.sync();
        { CTX; EpiStore E{HU, FF2}; run_gemm(c, XB, WUP, FF2, DM, E); }
        grid.sync();
        { CTX; ph_convgate(c, HU, G, p.ffn_conv_w + (size_t)layer * 3 * FF2, p.ffn_conv_b + (size_t)layer * FF2); }
        grid.sync();
        { CTX; EpiResid E{X}; run_gemm(c, G, WDN, DM, FF, E); }
        grid.sync();
        { CTX; ph_ln(c, X, XB, p.ln2_g + layer * DM, p.ln2_b + layer * DM); }
        if (layer < 3) { { CTX; convert_ffn(c, p, layer + 1); } grid.sync(); }
    }
}

extern "C" void kernel_launch(void* const* d_in, const int* in_sizes, int n_in, void* d_out, int out_size, void* d_ws, size_t ws_size, hipStream_t stream) {
    static int grid = 0;
    if (grid == 0) {
        if (n_in != 18 || out_size != T * DM || ws_size < WS_NEED) { fprintf(stderr, "kernel_launch: unexpected problem (n_in %d out %d ws %zu)\n", n_in, out_size, ws_size); grid = -1; return; }
        int dev = 0, cus = 0, per_cu = 0;
        (void)hipGetDevice(&dev); (void)hipDeviceGetAttribute(&cus, hipDeviceAttributeMultiprocessorCount, dev);
        (void)hipFuncSetAttribute((const void*)fwd, hipFuncAttributeMaxDynamicSharedMemorySize, LDS_BYTES);
        (void)hipOccupancyMaxActiveBlocksPerMultiprocessor(&per_cu, (const void*)fwd, 512, LDS_BYTES);
        if (per_cu < 1) per_cu = 1;
        grid = cus * per_cu;
    }
    if (grid < 0) return;
    P p{};
    p.x = (const float*)d_in[0]; p.pos = (const int*)d_in[1]; p.ev_w_in = (const float*)d_in[2]; p.ev_w_out = (const float*)d_in[3]; p.od_w_in = (const float*)d_in[4];
    p.od_conv_w = (const float*)d_in[5]; p.od_a_log = (const float*)d_in[6]; p.od_dt_bias = (const float*)d_in[7]; p.od_norm_w = (const float*)d_in[8]; p.od_w_out = (const float*)d_in[9];
    p.ffn_w_up = (const float*)d_in[10]; p.ffn_conv_w = (const float*)d_in[11]; p.ffn_conv_b = (const float*)d_in[12]; p.ffn_w_down = (const float*)d_in[13];
    p.ln1_g = (const float*)d_in[14]; p.ln1_b = (const float*)d_in[15]; p.ln2_g = (const float*)d_in[16]; p.ln2_b = (const float*)d_in[17];
    p.out = (float*)d_out; p.ws = (unsigned char*)d_ws;
    void* args[] = {&p};
    hipError_t e = hipLaunchCooperativeKernel((const void*)fwd, dim3(grid), dim3(512), args, LDS_BYTES, stream);
    if (e != hipSuccess) fprintf(stderr, "cooperative launch failed: %s (grid %d)\n", hipGetErrorString(e), grid);
}
```

```cpp
#include <hip/hip_runtime.h>
#include <hip/hip_cooperative_groups.h>
#include <cstdio>
namespace cg = cooperative_groups;

namespace pg8 {
#define PG8_LAS __attribute__((address_space(3)))
typedef unsigned short bf16_t;
typedef short bf16x8 __attribute__((ext_vector_type(8)));
typedef float f32x4 __attribute__((ext_vector_type(4)));
typedef unsigned u32x4 __attribute__((ext_vector_type(4)));
constexpr int BM = 256, BK = 64, HALF = 128, HTB = HALF * BK * 2  , STAGE_BYTES = 8 * HTB, NXCD = 8, WGM = 8;

__host__ __device__ __forceinline__ int lds_byte(int r, int c) { const int st = (r >> 4) * 2 + (c >> 5), rr = r & 15, cc = c & 31, ob = rr * 64 + cc * 2; return st * 1024 + (ob ^ (((ob >> 9) & 1) << 5)); }
__host__ __device__ __forceinline__ void stage_rc(int b, int& R, int& C) { const int st = b / 1024, sb = b % 1024, swz = sb ^ (((sb >> 9) & 1) << 5); R = (st >> 1) * 16 + swz / 64; C = (st & 1) * 32 + (swz % 64) / 2; }
__host__ __device__ __forceinline__ int perm32(int rho) { const int n = rho >> 4, i = rho & 15; return 8 * (i >> 2) + 4 * n + (i & 3); }

struct Unit { int pm, pn; };
struct Gemm { const bf16_t* A; const bf16_t* Bt; int M, N, K; };

struct StaticOrder {
    int nM, nN, nwg, G, c;
    __host__ __device__ void init(int M, int N, int G_, int c_) { nM = M / BM; nN = N / BM; nwg = nM * nN; G = G_; c = c_; }
    __host__ __device__ bool next(int i, Unit& u) const {
        const long L = (long)i * G + c; if (L >= nwg) return false;
        int wgid = (int)L; { const int q = nwg / NXCD, r = nwg % NXCD, xcd = wgid % NXCD, off = wgid / NXCD; wgid = (xcd < r ? xcd * (q + 1) : r * (q + 1) + (xcd - r) * q) + off; }
        const int nig = WGM * nN, gid = wgid / nig, fm = gid * WGM, gsz = (nM - fm) < WGM ? (nM - fm) : WGM;
        u.pm = fm + ((wgid % nig) % gsz); u.pn = (wgid % nig) / gsz; return true;
    }
    __device__ __forceinline__ void a_ready(const Unit&) const {}
    __device__ __forceinline__ void done(const Unit&) const {}
};
__device__ __forceinline__ unsigned cvt_pk_bf16(float lo, float hi) { unsigned r; asm volatile("v_cvt_pk_bf16_f32 %0, %1, %2" : "=v"(r) : "v"(lo), "v"(hi)); return r; }

template <class Epi, class Sched, bool STAMP = false>
__device__ __forceinline__ void gemm_phase(PG8_LAS unsigned char* lds, const Gemm g, const Sched& S, const Epi& E, unsigned long long* stamps) {
    int tid_ = threadIdx.x; asm volatile("" : "+v"(tid_));
    const int tid = tid_, wid = __builtin_amdgcn_readfirstlane(tid >> 6), lane = tid & 63, wr = wid >> 2, wc = wid & 3, fr = lane & 15, fq = lane >> 4;
    const int K = g.K, nt = K / BK;
    int ts_lo = 0, ts_hi = 0, nts = 0; const unsigned long long rt_entry = STAMP ? (unsigned long long)wall_clock64() : 0ull;
#define PG8_STAMP() do { if (STAMP && wid == 0 && nts < 64) { const unsigned long long _c = (unsigned long long)clock64(); \
        ts_lo = (lane == nts) ? (int)(unsigned)_c : ts_lo; ts_hi = (lane == nts) ? (int)(unsigned)(_c >> 32) : ts_hi; ++nts; } } while (0)
    PG8_STAMP();
    unsigned voffA[2], voffB[2];
#pragma unroll
    for (int i = 0; i < 2; ++i) { int R, C; stage_rc(tid * 16 + i * 8192, R, C); const int Rb = Epi::PERM ? ((R & ~31) + perm32(R & 31)) : R;
        voffA[i] = (unsigned)(R * K + C) * 2u; voffB[i] = (unsigned)(Rb * K + C) * 2u; }
    const size_t kstep = (size_t)(BK * 2);
    const size_t hstep = (size_t)HALF * K * 2;
    const size_t tstep = 2 * hstep;
    const unsigned ldsw = (unsigned)wid * 1024u;
    const int aoff = lds_byte(wr * 64 + fr, fq * 8), boff = lds_byte(wc * 32 + fr, fq * 8);
#define PG8_SA(b, h) (((b) * 2 + (h)) * HTB)
#define PG8_SB(b, h) ((4 + (b) * 2 + (h)) * HTB)
#define PG8_STAGE(bufoff, gbase, voff) do { _Pragma("unroll") for (int _i = 0; _i < 2; ++_i) \
        __builtin_amdgcn_global_load_lds((const unsigned*)((const char*)(gbase) + (voff)[_i]), (PG8_LAS unsigned*)(lds + (bufoff) + ldsw + _i * 8192), 16, 0, 0); } while (0)
#define PG8_LDA(dst, b, h) do { _Pragma("unroll") for (int m = 0; m < 4; ++m) _Pragma("unroll") for (int k = 0; k < 2; ++k) dst[m][k] = *(const PG8_LAS bf16x8*)(lds + PG8_SA(b, h) + aoff + m * 2048 + k * 1024); } while (0)
#define PG8_LDB(dst, b, h) do { _Pragma("unroll") for (int n = 0; n < 2; ++n) _Pragma("unroll") for (int k = 0; k < 2; ++k) dst[n][k] = *(const PG8_LAS bf16x8*)(lds + PG8_SB(b, h) + boff + n * 2048 + k * 1024); } while (0)
#define PG8_MMA(ai, bj, At, Bt) do { __builtin_amdgcn_s_setprio(1); _Pragma("unroll") for (int m = 0; m < 4; ++m) _Pragma("unroll") for (int n = 0; n < 2; ++n) _Pragma("unroll") for (int k = 0; k < 2; ++k) \
        acc[ai][bj][m][n] = __builtin_amdgcn_mfma_f32_16x16x32_bf16(Bt[n][k], At[m][k], acc[ai][bj][m][n], 0, 0, 0); __builtin_amdgcn_s_setprio(0); } while (0)
#define PG8_WAIT_V(n) asm volatile("s_waitcnt vmcnt(" #n ")" ::: "memory")
#define PG8_WAIT_L(n) asm volatile("s_waitcnt lgkmcnt(" #n ")" ::: "memory")
#define PG8_BAR __builtin_amdgcn_s_barrier()
#define PG8_SCHED __builtin_amdgcn_sched_barrier(0)
    Unit cur, nxt; int ui = 0;
    if (!S.next(0, cur)) return;
    f32x4 acc[2][2][4][2];
#pragma unroll
    for (int a = 0; a < 2; ++a)
#pragma unroll
        for (int b = 0; b < 2; ++b)
#pragma unroll
            for (int m = 0; m < 4; ++m)
#pragma unroll
                for (int n = 0; n < 2; ++n) acc[a][b][m][n] = (f32x4){0.f, 0.f, 0.f, 0.f};
    bf16x8 At[4][2], B0[2][2], B1[2][2];
    const char* cA = (const char*)g.A + (size_t)cur.pm * tstep; const char* cB = (const char*)g.Bt + (size_t)cur.pn * tstep;
    S.a_ready(cur);
    PG8_STAGE(PG8_SB(0, 0), cB, voffB); PG8_STAGE(PG8_SA(0, 0), cA, voffA); PG8_STAGE(PG8_SB(0, 1), cB + hstep, voffB); PG8_STAGE(PG8_SA(0, 1), cA + hstep, voffA);
    if (wr == 1) PG8_BAR;
    PG8_WAIT_V(4); PG8_BAR;
    PG8_STAGE(PG8_SB(1, 0), cB + kstep, voffB); PG8_STAGE(PG8_SA(1, 0), cA + kstep, voffA); PG8_STAGE(PG8_SB(1, 1), cB + hstep + kstep, voffB);
    PG8_WAIT_V(6); PG8_BAR;
    PG8_STAMP();
    for (;;) {
        const bool has_next = S.next(ui + 1, nxt);
        const char* nA = has_next ? (const char*)g.A + (size_t)nxt.pm * tstep : cA; const char* nB = has_next ? (const char*)g.Bt + (size_t)nxt.pn * tstep : cB;
        for (int t = 0; t < nt; t += 2) {
            const bool last = (t == nt - 2);
            const char* a1 = cA + (size_t)(t + 1) * kstep;
            const char* a2 = last ? nA : cA + (size_t)(t + 2) * kstep; const char* b2 = last ? nB : cB + (size_t)(t + 2) * kstep;
            const char* a3 = a2 + kstep; const char* b3 = b2 + kstep;
            if (last && has_next) S.a_ready(nxt);
            PG8_LDB(B0, 0, 0); PG8_SCHED; PG8_LDA(At, 0, 0); PG8_STAGE(PG8_SA(1, 1), a1 + hstep, voffA);
            PG8_WAIT_L(8); PG8_BAR; PG8_WAIT_L(0); PG8_MMA(0, 0, At, B0); PG8_BAR; PG8_SCHED;
            PG8_LDB(B1, 0, 1); PG8_STAGE(PG8_SB(0, 0), b2, voffB);
            PG8_BAR; PG8_WAIT_L(0); PG8_MMA(0, 1, At, B1); PG8_BAR;
            PG8_LDA(At, 0, 1); PG8_STAGE(PG8_SA(0, 0), a2, voffA);
            PG8_BAR; PG8_WAIT_L(0); PG8_MMA(1, 0, At, B0); PG8_BAR; PG8_SCHED;
            PG8_STAGE(PG8_SB(0, 1), b2 + hstep, voffB);
            PG8_WAIT_V(6); PG8_BAR; PG8_MMA(1, 1, At, B1); PG8_BAR;
            PG8_LDB(B0, 1, 0); PG8_SCHED; PG8_LDA(At, 1, 0); PG8_STAGE(PG8_SA(0, 1), a2 + hstep, voffA);
            PG8_WAIT_L(8); PG8_BAR; PG8_WAIT_L(0); PG8_MMA(0, 0, At, B0); PG8_BAR; PG8_SCHED;
            PG8_LDB(B1, 1, 1); PG8_STAGE(PG8_SB(1, 0), b3, voffB);
            PG8_BAR; PG8_WAIT_L(0); PG8_MMA(0, 1, At, B1); PG8_BAR;
            PG8_LDA(At, 1, 1); PG8_STAGE(PG8_SA(1, 0), a3, voffA);
            PG8_BAR; PG8_WAIT_L(0); PG8_MMA(1, 0, At, B0); PG8_BAR; PG8_SCHED;
            PG8_STAGE(PG8_SB(1, 1), b3 + hstep, voffB);
            PG8_WAIT_V(6); PG8_BAR; PG8_MMA(1, 1, At, B1); PG8_BAR;
        }
        PG8_STAMP();
        if constexpr (!Epi::AFTER_DRAIN) { E(acc, cur, wr, wc, fr, fq); S.done(cur); }
        PG8_STAMP();
        if (!has_next) break;
#pragma unroll
        for (int a = 0; a < 2; ++a)
#pragma unroll
            for (int b = 0; b < 2; ++b)
#pragma unroll
                for (int m = 0; m < 4; ++m)
#pragma unroll
                    for (int n = 0; n < 2; ++n) acc[a][b][m][n] = (f32x4){0.f, 0.f, 0.f, 0.f};
        cur = nxt; cA = nA; cB = nB; ++ui;
    }
    PG8_WAIT_V(0);
    if (wr == 0) PG8_BAR;
    PG8_BAR;
    if constexpr (Epi::AFTER_DRAIN) { E.fused(acc, cur, wr, wc, fr, fq, lds, wid, lane); S.done(cur); }
    PG8_STAMP();
    if (STAMP && wid == 0) { stamps[lane] = lane < nts ? (((unsigned long long)(unsigned)ts_hi << 32) | (unsigned)ts_lo) : 0ull;
        if (lane == 62) stamps[62] = rt_entry; if (lane == 63) stamps[63] = (unsigned long long)wall_clock64(); }
#undef PG8_STAMP
#undef PG8_SA
#undef PG8_SB
#undef PG8_STAGE
#undef PG8_LDA
#undef PG8_LDB
#undef PG8_MMA
#undef PG8_WAIT_V
#undef PG8_WAIT_L
#undef PG8_BAR
#undef PG8_SCHED
}
}

#define LAS __attribute__((address_space(3)))
using pg8::bf16_t; using pg8::bf16x8; using pg8::f32x4; using pg8::u32x4;
typedef unsigned u32x2 __attribute__((ext_vector_type(2)));

constexpr int T = 16384, SEQ = 2048, DM = 1024;
constexpr int EVW = 4608, ODW = 4096, ODLD = 4112, FF2 = 5632, FF = 2816;
constexpr float DN_ALPHA = 1.681792830507429f;
constexpr float LN_EPS = 1e-5f;
constexpr size_t MiB = 1u << 20;
constexpr size_t WS_EG = 65536, WS_BAR = 131072, WS_BAR_BYTES = 16384;
constexpr size_t WS_WMIN = 1 * MiB, WS_WMOUT = 10 * MiB, WS_WUP = 13 * MiB, WS_WDN = 24 * MiB;
constexpr size_t WS_XB = 30 * MiB, WS_COSA = 62 * MiB, WS_SINA = 66 * MiB, WS_COSB = 70 * MiB, WS_SINB = 70 * MiB + 512 * 1024, WS_AB = 71 * MiB;
constexpr size_t WS_BIG = 72 * MiB, WS_NEED = 352 * MiB;
constexpr size_t WS_HU = WS_BIG, WS_G = WS_BIG + 176 * MiB;
constexpr size_t WS_HP = WS_BIG, WS_MIXE = WS_BIG + 144 * MiB, WS_KVT = WS_BIG + 192 * MiB, WS_OG = WS_BIG + 224 * MiB, WS_MLM = WS_BIG + 272 * MiB, WS_MLL = WS_MLM + 1536 * 1024;
constexpr size_t WS_U = WS_BIG + 128 * MiB, WS_WM = WS_BIG + 160 * MiB, WS_QD = WS_BIG + 192 * MiB, WS_KDT = WS_BIG + 224 * MiB, WS_ATT = WS_BIG + 256 * MiB;
constexpr int LDS_BYTES = 147456;

struct P {
    const float* x; const int* pos; const float *ev_w_in, *ev_w_out, *od_w_in, *od_conv_w, *od_a_log, *od_dt_bias, *od_norm_w, *od_w_out,
        *ffn_w_up, *ffn_conv_w, *ffn_conv_b, *ffn_w_down, *ln1_g, *ln1_b, *ln2_g, *ln2_b;
    float* out; unsigned char* ws;
};
struct Ctx { LAS unsigned char* lds; int tid, lane, wave, q, r16, gw, ngw, gtid, nthr, bx, gx; };

__device__ __forceinline__ unsigned f2bf(float f) { unsigned u = __builtin_bit_cast(unsigned, f); return (u + 0x7fffu + ((u >> 16) & 1u)) >> 16; }
__device__ __forceinline__ unsigned pk2(float lo, float hi) { return f2bf(lo) | (f2bf(hi) << 16); }
__device__ __forceinline__ float bflo(unsigned w) { return __builtin_bit_cast(float, w << 16); }
__device__ __forceinline__ float bfhi(unsigned w) { return __builtin_bit_cast(float, w & 0xffff0000u); }
__device__ __forceinline__ float bf1(bf16_t b) { return __builtin_bit_cast(float, ((unsigned)b) << 16); }
#define UNPACK8(W_, F_) do { const u32x4 w_ = (W_); F_[0] = bflo(w_[0]); F_[1] = bfhi(w_[0]); F_[2] = bflo(w_[1]); F_[3] = bfhi(w_[1]); F_[4] = bflo(w_[2]); F_[5] = bfhi(w_[2]); F_[6] = bflo(w_[3]); F_[7] = bfhi(w_[3]); } while (0)
#define PACK8(F_) (u32x4){pk2(F_[0], F_[1]), pk2(F_[2], F_[3]), pk2(F_[4], F_[5]), pk2(F_[6], F_[7])}
__device__ __forceinline__ f32x4 mma(bf16x8 a, bf16x8 b, f32x4 c) { return __builtin_amdgcn_mfma_f32_16x16x32_bf16(a, b, c, 0, 0, 0); }
__device__ __forceinline__ float wave_sum(float v) {
#pragma unroll
    for (int o = 1; o < 64; o <<= 1) v += __shfl_xor(v, o);
    return v;
}
__device__ __forceinline__ float sum16(float v) { v += __shfl_xor(v, 1); v += __shfl_xor(v, 2); v += __shfl_xor(v, 4); v += __shfl_xor(v, 8); return v; }
__device__ __forceinline__ float max16(float v) { v = fmaxf(v, __shfl_xor(v, 1)); v = fmaxf(v, __shfl_xor(v, 2)); v = fmaxf(v, __shfl_xor(v, 4)); v = fmaxf(v, __shfl_xor(v, 8)); return v; }
__device__ __forceinline__ float silu_f(float x) { return x / (1.0f + __expf(-x)); }
#define LDS_WAIT() asm volatile("s_waitcnt lgkmcnt(0)" ::: "memory")

struct EpiStore {
    static constexpr bool PERM = true, AFTER_DRAIN = false;
    bf16_t* O; int ldc;
    __device__ __forceinline__ void operator()(const f32x4 (&acc)[2][2][4][2], const pg8::Unit& u, int wr, int wc, int fr, int fq) const {
        const int row0 = u.pm * 256 + wr * 64 + fr, col0 = u.pn * 256 + wc * 32 + 8 * fq;
#pragma unroll
        for (int ai = 0; ai < 2; ++ai)
#pragma unroll
            for (int m = 0; m < 4; ++m) { bf16_t* rowp = O + (size_t)(row0 + ai * 128 + m * 16) * ldc + col0;
#pragma unroll
                for (int bj = 0; bj < 2; ++bj) { const f32x4 v0 = acc[ai][bj][m][0], v1 = acc[ai][bj][m][1];
                    u32x4 w; w.x = pk2(v0[0], v0[1]); w.y = pk2(v0[2], v0[3]); w.z = pk2(v1[0], v1[1]); w.w = pk2(v1[2], v1[3]);
                    *(u32x4*)(rowp + bj * 128) = w; } }
    }
};
struct EpiResid {
    static constexpr bool PERM = false, AFTER_DRAIN = false;
    float* X;
    __device__ __forceinline__ void operator()(const f32x4 (&acc)[2][2][4][2], const pg8::Unit& u, int wr, int wc, int fr, int fq) const {
        const int row0 = u.pm * 256 + wr * 64 + fr, col0 = u.pn * 256 + wc * 32 + 4 * fq;
#pragma unroll
        for (int ai = 0; ai < 2; ++ai)
#pragma unroll
            for (int m = 0; m < 4; ++m) { float* rowp = X + (size_t)(row0 + ai * 128 + m * 16) * DM + col0;
#pragma unroll
                for (int bj = 0; bj < 2; ++bj)
#pragma unroll
                    for (int n = 0; n < 2; ++n) { f32x4* pp = (f32x4*)(rowp + bj * 128 + n * 16); *pp = *pp * DN_ALPHA + acc[ai][bj][m][n]; } }
    }
};
template <class Epi> __device__ __forceinline__ void run_gemm(const Ctx& c, const bf16_t* A, const bf16_t* Bt, int N, int K, const Epi& E) {
    pg8::Gemm g{A, Bt, T, N, K}; pg8::StaticOrder S; S.init(T, N, c.gx, c.bx);
    pg8::gemm_phase<Epi, pg8::StaticOrder, false>((PG8_LAS unsigned char*)c.lds, g, S, E, nullptr);
}

__device__ __forceinline__ void transpose_item(const float* W, int K, int ldw, int N, bf16_t* WT, LAS float* scr, int item, int lane) {
    const int nblk = N / 32, kb = item / nblk, nb = item % nblk, k0 = 64 * kb, n0 = 32 * nb;
#pragma unroll 8
    for (int i = 0; i < 32; ++i) { const int kk = 2 * i + (lane >> 5); scr[kk * 33 + (lane & 31)] = W[(size_t)(k0 + kk) * ldw + n0 + (lane & 31)]; }
    LDS_WAIT();
    const int ch = lane & 7;
#pragma unroll
    for (int j = 0; j < 4; ++j) { const int n = (lane >> 3) + 8 * j; const LAS float* s = scr + (8 * ch) * 33 + n;
        u32x4 o; o.x = pk2(s[0 * 33], s[1 * 33]); o.y = pk2(s[2 * 33], s[3 * 33]); o.z = pk2(s[4 * 33], s[5 * 33]); o.w = pk2(s[6 * 33], s[7 * 33]);
        *(u32x4*)(WT + (size_t)(n0 + n) * K + k0 + 8 * ch) = o; }
    LDS_WAIT();
}
__device__ __forceinline__ void convert2(const Ctx& c, const float* W1, int K1, int ld1, int N1, bf16_t* WT1, const float* W2, int K2, int ld2, int N2, bf16_t* WT2) {
    LAS float* scr = (LAS float*)(c.lds + c.wave * 16384);
    const int I1 = (K1 / 64) * (N1 / 32), I2 = (K2 / 64) * (N2 / 32);
    for (int it = c.gw; it < I1 + I2; it += c.ngw) {
        if (it < I1) transpose_item(W1, K1, ld1, N1, WT1, scr, it, c.lane);
        else transpose_item(W2, K2, ld2, N2, WT2, scr, it - I1, c.lane);
    }
}
__device__ __forceinline__ void convert_mixer(const Ctx& c, const P& p, int layer) {
    const int j = layer >> 1; bf16_t* win = (bf16_t*)(p.ws + WS_WMIN); bf16_t* wout = (bf16_t*)(p.ws + WS_WMOUT);
    if ((layer & 1) == 0) convert2(c, p.ev_w_in + (size_t)j * DM * EVW, DM, EVW, EVW, win, p.ev_w_out + (size_t)j * 1536 * DM, 1536, DM, DM, wout);
    else convert2(c, p.od_w_in + (size_t)j * DM * ODLD, DM, ODLD, ODW, win, p.od_w_out + (size_t)j * DM * DM, DM, DM, DM, wout);
}
__device__ __forceinline__ void convert_ffn(const Ctx& c, const P& p, int layer) {
    convert2(c, p.ffn_w_up + (size_t)layer * DM * FF2, DM, FF2, FF2, (bf16_t*)(p.ws + WS_WUP), p.ffn_w_down + (size_t)layer * FF * DM, FF, DM, DM, (bf16_t*)(p.ws + WS_WDN));
}

__device__ __forceinline__ void ph_copy_x(const Ctx& c, const float* x, float* X, bf16_t* XB) {
    for (int m = c.gw; m < T; m += c.ngw) {
#pragma unroll
        for (int j = 0; j < 4; ++j) { const f32x4 v = ((const f32x4*)(x + (size_t)m * DM))[c.lane + 64 * j];
            ((f32x4*)(X + (size_t)m * DM))[c.lane + 64 * j] = v;
            ((u32x2*)(XB + (size_t)m * DM))[c.lane + 64 * j] = (u32x2){pk2(v[0], v[1]), pk2(v[2], v[3])}; }
    }
}
__device__ __forceinline__ void ph_ln(const Ctx& c, float* X, bf16_t* XB, const float* g, const float* b) {
    for (int m = c.gw; m < T; m += c.ngw) {
        f32x4* xr = (f32x4*)(X + (size_t)m * DM) + c.lane;
        f32x4 v[4]; float s = 0.f;
#pragma unroll
        for (int j = 0; j < 4; ++j) { v[j] = xr[64 * j]; s += (v[j][0] + v[j][1]) + (v[j][2] + v[j][3]); }
        const float mean = wave_sum(s) * (1.f / DM); float s2 = 0.f;
#pragma unroll
        for (int j = 0; j < 4; ++j) { v[j] = v[j] - mean; s2 += (v[j][0] * v[j][0] + v[j][1] * v[j][1]) + (v[j][2] * v[j][2] + v[j][3] * v[j][3]); }
        const float rstd = 1.f / sqrtf(wave_sum(s2) * (1.f / DM) + LN_EPS);
#pragma unroll
        for (int j = 0; j < 4; ++j) { const f32x4 gg = ((const f32x4*)g)[c.lane + 64 * j], bb = ((const f32x4*)b)[c.lane + 64 * j];
            const f32x4 y = v[j] * rstd * gg + bb; xr[64 * j] = y;
            ((u32x2*)(XB + (size_t)m * DM))[c.lane + 64 * j] = (u32x2){pk2(y[0], y[1]), pk2(y[2], y[3])}; }
    }
}
__device__ __forceinline__ void ph_rot_tables(const Ctx& c, const int* pos, float* cosA, float* sinA, float* cosB, float* sinB) {
    for (int idx = c.gtid; idx < T * 72; idx += c.nthr) {
        const int t = idx / 72, i = idx % 72; const float pf = (float)pos[t];
        float inv; if (i < 64) inv = exp2f(-(float)i * (2.0f / 128.0f) * 13.287712379549449f); else inv = exp2f(-(float)(i - 64) * (2.0f / 16.0f) * 18.931568569324174f);
        const float ang = pf * inv; const double rev = (double)ang * 0.15915494309189535; const float fr = (float)(rev - floor(rev));
        const float sn = __builtin_amdgcn_sinf(fr), cs = __builtin_amdgcn_cosf(fr);
        if (i < 64) { cosA[t * 64 + i] = cs; sinA[t * 64 + i] = sn; } else { cosB[t * 8 + i - 64] = cs; sinB[t * 8 + i - 64] = sn; }
    }
}
__device__ __forceinline__ void ph_convgate(const Ctx& c, const bf16_t* HU, bf16_t* G, const float* cw, const float* cb) {
    constexpr int RUN = 16, NCG = FF / 8;
    for (int it = c.gtid; it < (T / RUN) * NCG; it += c.nthr) {
        const int run = it / NCG, f0 = (it % NCG) * 8, t0 = run * RUN;
        float wg[3][8], wv[3][8], bg[8], bv[8], hg0[8], hg1[8], hv0[8], hv1[8];
#pragma unroll
        for (int j = 0; j < 3; ++j)
#pragma unroll
            for (int i = 0; i < 8; ++i) { wg[j][i] = cw[j * FF2 + f0 + i]; wv[j][i] = cw[j * FF2 + FF + f0 + i]; }
#pragma unroll
        for (int i = 0; i < 8; ++i) { bg[i] = cb[f0 + i]; bv[i] = cb[FF + f0 + i]; hg0[i] = hg1[i] = hv0[i] = hv1[i] = 0.f; }
        if ((t0 & (SEQ - 1)) != 0) {
            u32x4 a = *(const u32x4*)(HU + (size_t)(t0 - 2) * FF2 + f0), b = *(const u32x4*)(HU + (size_t)(t0 - 2) * FF2 + FF + f0); UNPACK8(a, hg0); UNPACK8(b, hv0);
            a = *(const u32x4*)(HU + (size_t)(t0 - 1) * FF2 + f0); b = *(const u32x4*)(HU + (size_t)(t0 - 1) * FF2 + FF + f0); UNPACK8(a, hg1); UNPACK8(b, hv1);
        }
#pragma unroll 2
        for (int tt = 0; tt < RUN; ++tt) {
            const size_t t = t0 + tt; float cg_[8], cv_[8], o[8];
            const u32x4 a = *(const u32x4*)(HU + t * FF2 + f0), b = *(const u32x4*)(HU + t * FF2 + FF + f0); UNPACK8(a, cg_); UNPACK8(b, cv_);
#pragma unroll
            for (int i = 0; i < 8; ++i) { const float yg = bg[i] + wg[0][i] * hg0[i] + wg[1][i] * hg1[i] + wg[2][i] * cg_[i]; const float yv = bv[i] + wv[0][i] * hv0[i] + wv[1][i] * hv1[i] + wv[2][i] * cv_[i];
                o[i] = silu_f(yg) * yv; hg0[i] = hg1[i]; hg1[i] = cg_[i]; hv0[i] = hv1[i]; hv1[i] = cv_[i]; }
            *(u32x4*)(G + t * FF + f0) = PACK8(o);
        }
    }
}

template <class R> __device__ __forceinline__ void stage_N(LAS bf16_t* dst, int dld, R src_row, int nrows, int ncols, int tid) {
    const int cpr = ncols >> 3, nch = nrows * cpr;
    for (int idx = tid; idx < nch; idx += 512) { const int r = idx / cpr, cc = idx % cpr; const bf16_t* s = src_row(r);
        u32x4 w = (u32x4){0u, 0u, 0u, 0u}; if (s) w = *(const u32x4*)(s + cc * 8);
        *(LAS u32x4*)(dst + r * dld + cc * 8) = w; }
}
template <class R, class F> __device__ __forceinline__ void stage_T(LAS bf16_t* dst, int dld, R src_row, int nrows, int ncols, int tid, F scale) {
    const int nch = nrows * (ncols >> 3);
    for (int idx = tid; idx < nch; idx += 512) { const int r = idx & (nrows - 1), cc = idx / nrows; const bf16_t* s = src_row(r);
        u32x4 w = (u32x4){0u, 0u, 0u, 0u}; if (s) w = *(const u32x4*)(s + cc * 8);
        float f[8]; UNPACK8(w, f); const float sc = scale(r);
#pragma unroll
        for (int i = 0; i < 8; ++i) dst[(cc * 8 + i) * dld + r] = (bf16_t)f2bf(f[i] * sc); }
}

__device__ __forceinline__ void rot8(bf16_t* p1, bf16_t* p2, const float* cs, const float* sn, float sc) {
    const u32x4 a = *(const u32x4*)p1, b = *(const u32x4*)p2; float x1[8], x2[8], o1[8], o2[8]; UNPACK8(a, x1); UNPACK8(b, x2);
#pragma unroll
    for (int i = 0; i < 8; ++i) { const float c_ = cs[i], s_ = sn[i]; o1[i] = (x1[i] * c_ - x2[i] * s_) * sc; o2[i] = (x2[i] * c_ + x1[i] * s_) * sc; }
    *(u32x4*)p1 = PACK8(o1); *(u32x4*)p2 = PACK8(o2);
}
__device__ __forceinline__ void ph_rotary(const Ctx& c, bf16_t* HP, const float* cosA, const float* sinA, const float* cosB, const float* sinB) {
    for (int idx = c.gtid; idx < T * 80; idx += c.nthr) {
        const int t = idx / 80, it = idx % 80; bf16_t* row = HP + (size_t)t * EVW;
        if (it < 64) { const int which = it >> 5, h = (it >> 3) & 3, ci = it & 7; bf16_t* p1 = row + which * 512 + h * 128 + ci * 8;
            rot8(p1, p1 + 64, cosA + t * 64 + ci * 8, sinA + t * 64 + ci * 8, which ? 0.08838834764831845f : 1.0f); }
        else if (it < 72) { const int h = it - 64; bf16_t* base = row + 3072 + h * 64; const float sc = 0.125f * 1.4426950408889634f;
            rot8(base, base + 8, cosB + t * 8, sinB + t * 8, sc);
#pragma unroll
            for (int ch = 2; ch < 8; ++ch) { const u32x4 a = *(const u32x4*)(base + ch * 8); float f[8]; UNPACK8(a, f);
#pragma unroll
                for (int i = 0; i < 8; ++i) f[i] *= sc;
                *(u32x4*)(base + ch * 8) = PACK8(f); } }
        else { const int h = it - 72; bf16_t* base = row + 3584 + h * 64; rot8(base, base + 8, cosB + t * 8, sinB + t * 8, 1.0f); }
    }
}

__device__ __forceinline__ float ret_lg2(int h) { return log2f(1.0f - exp2f(-5.0f - (float)h)); }
__device__ __forceinline__ void item_ret_kv(const Ctx& c, int item, const bf16_t* HP, bf16_t* KVT) {
    const int bh = item >> 4, b = bh >> 2, h = bh & 3, n = item & 15; const size_t t0 = (size_t)b * SEQ + 128 * n; const float lg2 = ret_lg2(h);
    LAS bf16_t* sKT = (LAS bf16_t*)c.lds; LAS bf16_t* sVT = (LAS bf16_t*)(c.lds + 34816);
    stage_T(sKT, 136, [&](int j) { return HP + (t0 + j) * EVW + 512 + h * 128; }, 128, 128, c.tid, [&](int j) { return exp2f((float)(127 - j) * lg2); });
    stage_T(sVT, 136, [&](int j) { return HP + (t0 + j) * EVW + 1024 + h * 256; }, 128, 256, c.tid, [&](int) { return 1.0f; });
    __syncthreads();
    f32x4 acc[16];
#pragma unroll
    for (int nt = 0; nt < 16; ++nt) acc[nt] = (f32x4){0.f, 0.f, 0.f, 0.f};
#pragma unroll
    for (int ks = 0; ks < 4; ++ks) { const bf16x8 a = *(const LAS bf16x8*)(sKT + (16 * c.wave + c.r16) * 136 + 32 * ks + 8 * c.q);
#pragma unroll
        for (int nt = 0; nt < 16; ++nt) { const bf16x8 bb = *(const LAS bf16x8*)(sVT + (16 * nt + c.r16) * 136 + 32 * ks + 8 * c.q); acc[nt] = mma(a, bb, acc[nt]); } }
#pragma unroll
    for (int nt = 0; nt < 16; ++nt) { const int e = 16 * nt + c.r16;
        *(u32x2*)(KVT + ((size_t)item * 256 + e) * 128 + 16 * c.wave + 4 * c.q) = (u32x2){pk2(acc[nt][0], acc[nt][1]), pk2(acc[nt][2], acc[nt][3])}; }
    __syncthreads();
}
__device__ __forceinline__ void ph_ret_scan(const Ctx& c, bf16_t* KVT) {
    for (int idx = c.gtid; idx < 32 * 4096; idx += c.nthr) {
        const int bh = idx >> 12, ch = idx & 4095, h = bh & 3; const float gch = exp2f(128.0f * ret_lg2(h));
        float st[8];
#pragma unroll
        for (int i = 0; i < 8; ++i) st[i] = 0.f;
        for (int n = 0; n < 16; ++n) { u32x4* ptr = (u32x4*)(KVT + (size_t)(bh * 16 + n) * 32768 + ch * 8); const u32x4 w = *ptr; float tmp[8]; UNPACK8(w, tmp);
            *ptr = PACK8(st);
#pragma unroll
            for (int i = 0; i < 8; ++i) st[i] = st[i] * gch + tmp[i]; }
    }
}
__device__ __forceinline__ void item_ret_out(const Ctx& c, int item, const bf16_t* HP, const bf16_t* RT, bf16_t* MIX) {
    const int bh = item >> 4, b = bh >> 2, h = bh & 3, n = item & 15; const size_t t0 = (size_t)b * SEQ + 128 * n; const float lg2 = ret_lg2(h);
    LAS bf16_t* sK = (LAS bf16_t*)c.lds; LAS bf16_t* sVT = (LAS bf16_t*)(c.lds + 34816); LAS bf16_t* sP = (LAS bf16_t*)(c.lds + 34816 + 69632) + c.wave * 16 * 136;
    stage_N(sK, 136, [&](int j) { return HP + (t0 + j) * EVW + 512 + h * 128; }, 128, 128, c.tid);
    stage_T(sVT, 136, [&](int j) { return HP + (t0 + j) * EVW + 1024 + h * 256; }, 128, 256, c.tid, [&](int) { return 1.0f; });
    bf16x8 aQ[4];
    { const bf16_t* qrow = HP + (t0 + 16 * c.wave + c.r16) * EVW + h * 128;
#pragma unroll
      for (int ks = 0; ks < 4; ++ks) aQ[ks] = *(const bf16x8*)(qrow + 32 * ks + 8 * c.q); }
    __syncthreads();
#pragma unroll
    for (int nt = 0; nt < 8; ++nt) {
        if (nt <= c.wave) { f32x4 s = (f32x4){0.f, 0.f, 0.f, 0.f};
#pragma unroll
            for (int ks = 0; ks < 4; ++ks) { const bf16x8 bb = *(const LAS bf16x8*)(sK + (16 * nt + c.r16) * 136 + 32 * ks + 8 * c.q); s = mma(aQ[ks], bb, s); }
#pragma unroll
            for (int jj = 0; jj < 4; ++jj) { const int i = 16 * c.wave + 4 * c.q + jj, j = 16 * nt + c.r16; const float pv = (i >= j) ? s[jj] * exp2f((float)(i - j) * lg2) : 0.f;
                sP[(4 * c.q + jj) * 136 + 16 * nt + c.r16] = (bf16_t)f2bf(pv); } }
        else if (nt == c.wave + 1) {
#pragma unroll
            for (int jj = 0; jj < 4; ++jj) sP[(4 * c.q + jj) * 136 + 16 * nt + c.r16] = (bf16_t)0; }
    }
    f32x4 acc[16];
#pragma unroll
    for (int nt = 0; nt < 16; ++nt) acc[nt] = (f32x4){0.f, 0.f, 0.f, 0.f};
    const bf16_t* rt = RT + (size_t)item * 32768;
#pragma unroll
    for (int ks = 0; ks < 4; ++ks)
#pragma unroll
        for (int nt = 0; nt < 16; ++nt) { const bf16x8 bb = *(const bf16x8*)(rt + (16 * nt + c.r16) * 128 + 32 * ks + 8 * c.q); acc[nt] = mma(aQ[ks], bb, acc[nt]); }
    {   float xi[4];
#pragma unroll
        for (int jj = 0; jj < 4; ++jj) xi[jj] = exp2f((float)(16 * c.wave + 4 * c.q + jj + 1) * lg2);
#pragma unroll
        for (int nt = 0; nt < 16; ++nt)
#pragma unroll
            for (int jj = 0; jj < 4; ++jj) acc[nt][jj] *= xi[jj]; }
    LDS_WAIT();
#pragma unroll
    for (int ks = 0; ks < 4; ++ks) {
        if (ks <= (c.wave >> 1)) { const bf16x8 a = *(const LAS bf16x8*)(sP + c.r16 * 136 + 32 * ks + 8 * c.q);
#pragma unroll
            for (int nt = 0; nt < 16; ++nt) { const bf16x8 bb = *(const LAS bf16x8*)(sVT + (16 * nt + c.r16) * 136 + 32 * ks + 8 * c.q); acc[nt] = mma(a, bb, acc[nt]); } }
    }
    float rstd[4];
#pragma unroll
    for (int jj = 0; jj < 4; ++jj) { float ss = 0.f;
#pragma unroll
        for (int nt = 0; nt < 16; ++nt) ss += acc[nt][jj] * acc[nt][jj];
        ss = sum16(ss); rstd[jj] = 1.f / sqrtf(ss * (1.f / 256.f) + LN_EPS); }
#pragma unroll
    for (int jj = 0; jj < 4; ++jj) { const size_t t = t0 + 16 * c.wave + 4 * c.q + jj;
#pragma unroll
        for (int nt = 0; nt < 16; ++nt) { const int e = 16 * nt + c.r16; const float gt = bf1(HP[t * EVW + 2048 + h * 256 + e]);
            MIX[t * 1536 + h * 256 + e] = (bf16_t)f2bf(acc[nt][jj] * rstd[jj] * silu_f(gt)); } }
    __syncthreads();
}

__device__ __forceinline__ void item_dil(const Ctx& c, int g, int ii, const bf16_t* HP, bf16_t* OG, float* MLm, float* MLl) {
    const int ld = 2 * g, d = 1 << ld;
    const int bh = ii >> 4, b = bh >> 3, h = bh & 7, rem = ii & 15, r = rem & (d - 1), j = rem >> ld;
    LAS bf16_t* sK = (LAS bf16_t*)c.lds; LAS bf16_t* sVT = (LAS bf16_t*)(c.lds + 36864); LAS bf16_t* sP = (LAS bf16_t*)(c.lds + 36864 + 35840) + c.wave * 16 * 168;
    const size_t tb = (size_t)b * SEQ;
    stage_N(sK, 72, [&](int kk) -> const bf16_t* { const int lk = 128 * (j - 1) + kk; return lk >= 0 ? HP + (tb + (size_t)lk * d + r) * EVW + 3584 + h * 64 : nullptr; }, 256, 64, c.tid);
    stage_T(sVT, 280, [&](int kk) -> const bf16_t* { const int lk = 128 * (j - 1) + kk; return lk >= 0 ? HP + (tb + (size_t)lk * d + r) * EVW + 4096 + h * 64 : nullptr; }, 256, 64, c.tid, [&](int) { return 1.0f; });
    for (int idx = c.tid; idx < 64 * 24; idx += 512) sVT[(idx / 24) * 280 + 256 + idx % 24] = (bf16_t)0;
    bf16x8 aQ[2];
    { const bf16_t* qrow = HP + (tb + (size_t)(128 * j + 16 * c.wave + c.r16) * d + r) * EVW + 3072 + h * 64;
      aQ[0] = *(const bf16x8*)(qrow + 8 * c.q); aQ[1] = *(const bf16x8*)(qrow + 32 + 8 * c.q); }
    *(LAS u32x2*)(sP + (c.lane >> 2) * 168 + 144 + 4 * (c.lane & 3)) = (u32x2){0u, 0u};
    __syncthreads();
    f32x4 s[9]; float mx[4] = {-INFINITY, -INFINITY, -INFINITY, -INFINITY};
#pragma unroll
    for (int tt = 0; tt < 9; ++tt) { const int kt = c.wave + tt; f32x4 a = (f32x4){0.f, 0.f, 0.f, 0.f};
#pragma unroll
        for (int ks = 0; ks < 2; ++ks) { const bf16x8 bb = *(const LAS bf16x8*)(sK + (16 * kt + c.r16) * 72 + 32 * ks + 8 * c.q); a = mma(aQ[ks], bb, a); }
#pragma unroll
        for (int jj = 0; jj < 4; ++jj) { const int i = 16 * c.wave + 4 * c.q + jj, kk = 16 * kt + c.r16, dist = 128 + i - kk;
            const bool ok = (dist >= 0) && (dist <= 128) && (j > 0 || kk >= 128);
            a[jj] = ok ? a[jj] : -INFINITY; mx[jj] = fmaxf(mx[jj], a[jj]); }
        s[tt] = a; }
    float l[4];
#pragma unroll
    for (int jj = 0; jj < 4; ++jj) { mx[jj] = max16(mx[jj]); l[jj] = 0.f; }
#pragma unroll
    for (int tt = 0; tt < 9; ++tt)
#pragma unroll
        for (int jj = 0; jj < 4; ++jj) { const float pv = exp2f(s[tt][jj] - mx[jj]); l[jj] += pv; sP[(4 * c.q + jj) * 168 + 16 * tt + c.r16] = (bf16_t)f2bf(pv); }
#pragma unroll
    for (int jj = 0; jj < 4; ++jj) l[jj] = sum16(l[jj]);
    LDS_WAIT();
    f32x4 o[4];
#pragma unroll
    for (int et = 0; et < 4; ++et) o[et] = (f32x4){0.f, 0.f, 0.f, 0.f};
#pragma unroll
    for (int ks = 0; ks < 5; ++ks) { const bf16x8 a = *(const LAS bf16x8*)(sP + c.r16 * 168 + 32 * ks + 8 * c.q);
#pragma unroll
        for (int et = 0; et < 4; ++et) { const bf16x8 bb = *(const LAS bf16x8*)(sVT + (16 * et + c.r16) * 280 + 16 * c.wave + 32 * ks + 8 * c.q); o[et] = mma(a, bb, o[et]); } }
#pragma unroll
    for (int jj = 0; jj < 4; ++jj) { const int i = 16 * c.wave + 4 * c.q + jj; const size_t tq = tb + (size_t)(128 * j + i) * d + r; const float inv = 1.f / l[jj];
#pragma unroll
        for (int et = 0; et < 4; ++et) OG[((size_t)g * T + tq) * 512 + h * 64 + 16 * et + c.r16] = (bf16_t)f2bf(o[et][jj] * inv);
        if (c.r16 == 0) { MLm[((size_t)g * T + tq) * 8 + h] = mx[jj]; MLl[((size_t)g * T + tq) * 8 + h] = l[jj]; } }
    __syncthreads();
}
__device__ __forceinline__ void ph_dil_combine(const Ctx& c, const bf16_t* OG, const float* MLm, const float* MLl, bf16_t* MIX) {
    for (int idx = c.gtid; idx < T * 64; idx += c.nthr) {
        const int t = idx >> 6, h = (idx >> 3) & 7, ch = idx & 7;
        float m[3], w[3];
#pragma unroll
        for (int g = 0; g < 3; ++g) { m[g] = MLm[((size_t)g * T + t) * 8 + h]; w[g] = MLl[((size_t)g * T + t) * 8 + h]; }
        const float mm = fmaxf(m[0], fmaxf(m[1], m[2])); float ws = 0.f;
#pragma unroll
        for (int g = 0; g < 3; ++g) { w[g] *= exp2f(m[g] - mm); ws += w[g]; }
        float acc[8];
#pragma unroll
        for (int i = 0; i < 8; ++i) acc[i] = 0.f;
#pragma unroll
        for (int g = 0; g < 3; ++g) { const u32x4 a = *(const u32x4*)(OG + ((size_t)g * T + t) * 512 + h * 64 + ch * 8); float f[8]; UNPACK8(a, f);
#pragma unroll
            for (int i = 0; i < 8; ++i) acc[i] += w[g] * f[i]; }
        const float inv = 1.f / ws;
#pragma unroll
        for (int i = 0; i < 8; ++i) acc[i] *= inv;
        *(u32x4*)(MIX + (size_t)t * 1536 + 1024 + h * 64 + ch * 8) = PACK8(acc);
    }
}

__device__ __forceinline__ void ph_ab(const Ctx& c, const float* X, const float* W  , float* AB) {
    for (int m = c.gw; m < T; m += c.ngw) {
        f32x4 a[4];
#pragma unroll
        for (int i = 0; i < 4; ++i) a[i] = (f32x4){0.f, 0.f, 0.f, 0.f};
#pragma unroll
        for (int j = 0; j < 4; ++j) { const f32x4 xv = ((const f32x4*)(X + (size_t)m * DM))[c.lane + 64 * j];
#pragma unroll
            for (int e = 0; e < 4; ++e) { const float* wr = W + (size_t)(4 * c.lane + 256 * j + e) * ODLD + ODW;
#pragma unroll
                for (int i = 0; i < 4; ++i) a[i] += ((const f32x4*)wr)[i] * xv[e]; } }
#pragma unroll
        for (int i = 0; i < 4; ++i)
#pragma unroll
            for (int e = 0; e < 4; ++e) a[i][e] = wave_sum(a[i][e]);
        if (c.lane == 0) {
#pragma unroll
            for (int i = 0; i < 4; ++i) ((f32x4*)(AB + (size_t)m * 16))[i] = a[i]; }
    }
}
__device__ __forceinline__ void item_gdn_chunk(const Ctx& c, int item, const bf16_t* HP, const float* AB, const float* convw, float alog, float dtb,
                                               bf16_t* U, bf16_t* WM, bf16_t* QD, bf16_t* KDT, bf16_t* ATT, float* EG) {
    const int bh = item >> 5, b = bh >> 3, h = bh & 7, n = item & 31; const size_t t0 = (size_t)b * SEQ + 64 * n;
    LAS bf16_t* sQ = (LAS bf16_t*)c.lds; LAS bf16_t* sK = (LAS bf16_t*)(c.lds + 17408); LAS bf16_t* sKD = (LAS bf16_t*)(c.lds + 34816);
    LAS float* sRHS = (LAS float*)(c.lds + 53248); LAS float* sA = (LAS float*)(c.lds + 119808); LAS float* sBeta = (LAS float*)(c.lds + 137216); LAS float* sGc = (LAS float*)(c.lds + 137472);
    if (c.wave == 0) {
        const float braw = AB[(t0 + c.lane) * 16 + h], araw = AB[(t0 + c.lane) * 16 + 8 + h] + dtb;
        const float beta = 1.f / (1.f + __expf(-braw));
        const float sp = fmaxf(araw, 0.f) + log1pf(__expf(-fabsf(araw)));
        float g = -__expf(alog) * sp;
#pragma unroll
        for (int off = 1; off < 64; off <<= 1) { const float v = __shfl_up(g, off); if (c.lane >= off) g += v; }
        sBeta[c.lane] = beta; sGc[c.lane] = g; if (c.lane == 63) EG[item] = __expf(g);
    }
    __syncthreads();
    const float glast = sGc[63];
#pragma unroll
    for (int which = 0; which < 3; ++which)
#pragma unroll
        for (int pass = 0; pass < 2; ++pass) {
            const int tok = 32 * pass + 4 * c.wave + c.q, col = which * 1024 + h * 128 + 8 * c.r16; const size_t t = t0 + tok; const int tin = (int)(t & (SEQ - 1));
            float y[8];
#pragma unroll
            for (int i = 0; i < 8; ++i) y[i] = 0.f;
#pragma unroll
            for (int jt = 0; jt < 4; ++jt) { if (tin - 3 + jt >= 0) { const u32x4 w = *(const u32x4*)(HP + (t - 3 + jt) * ODW + col); float f[8]; UNPACK8(w, f);
                const f32x4 c0 = *(const f32x4*)(convw + jt * 3072 + col), c1 = *(const f32x4*)(convw + jt * 3072 + col + 4);
#pragma unroll
                for (int i = 0; i < 4; ++i) { y[i] += c0[i] * f[i]; y[4 + i] += c1[i] * f[4 + i]; } } }
#pragma unroll
            for (int i = 0; i < 8; ++i) y[i] = silu_f(y[i]);
            const float gcv = sGc[tok], betav = sBeta[tok];
            if (which < 2) { float ss = 0.f;
#pragma unroll
                for (int i = 0; i < 8; ++i) ss += y[i] * y[i];
                ss = sum16(ss); const float rn = (1.f / sqrtf(ss + 1e-6f)) * (which == 0 ? 0.08838834764831845f : 1.0f);
#pragma unroll
                for (int i = 0; i < 8; ++i) y[i] *= rn; }
            if (which == 0) { *(LAS u32x4*)(sQ + tok * 136 + 8 * c.r16) = PACK8(y); const float eg = __expf(gcv); float z[8];
#pragma unroll
                for (int i = 0; i < 8; ++i) z[i] = y[i] * eg;
                *(u32x4*)(QD + t * DM + h * 128 + 8 * c.r16) = PACK8(z); }
            else if (which == 1) { *(LAS u32x4*)(sK + tok * 136 + 8 * c.r16) = PACK8(y); const float e1 = betav * __expf(gcv), e2 = __expf(glast - gcv);
#pragma unroll
                for (int i = 0; i < 8; ++i) { sRHS[tok * 260 + 128 + 8 * c.r16 + i] = y[i] * e1; sKD[(8 * c.r16 + i) * 72 + tok] = (bf16_t)f2bf(y[i] * e2); } }
            else {
#pragma unroll
                for (int i = 0; i < 8; ++i) sRHS[tok * 260 + 8 * c.r16 + i] = y[i] * betav; }
        }
    __syncthreads();
#pragma unroll
    for (int ts = 0; ts < 2; ++ts) { const int idx = 2 * c.wave + ts, mt = idx >> 2, nt = idx & 3; f32x4 aK = (f32x4){0.f, 0.f, 0.f, 0.f}, aQ = aK;
#pragma unroll
        for (int ks = 0; ks < 4; ++ks) { const bf16x8 ak = *(const LAS bf16x8*)(sK + (16 * mt + c.r16) * 136 + 32 * ks + 8 * c.q), aq = *(const LAS bf16x8*)(sQ + (16 * mt + c.r16) * 136 + 32 * ks + 8 * c.q),
                bb = *(const LAS bf16x8*)(sK + (16 * nt + c.r16) * 136 + 32 * ks + 8 * c.q); aK = mma(ak, bb, aK); aQ = mma(aq, bb, aQ); }
#pragma unroll
        for (int jj = 0; jj < 4; ++jj) { const int i = 16 * mt + 4 * c.q + jj, jx = 16 * nt + c.r16; const float dec = (i >= jx) ? __expf(sGc[i] - sGc[jx]) : 0.f;
            sA[i * 68 + jx] = (i > jx) ? sBeta[i] * aK[jj] * dec : 0.f;
            ATT[((size_t)item * 64 + i) * 64 + jx] = (bf16_t)f2bf(aQ[jj] * dec); } }
    for (int idx = c.tid; idx < 1024; idx += 512) { const int dd = idx >> 3, cc = idx & 7; *(u32x4*)(KDT + ((size_t)item * 128 + dd) * 64 + cc * 8) = *(const LAS u32x4*)(sKD + dd * 72 + cc * 8); }
    __syncthreads();
    if (c.tid < 256) { const int col = c.tid; float x[64]; LAS float* sAv = sA; asm volatile("" : "+v"(sAv)); LAS float* sRv = sRHS + col; asm volatile("" : "+v"(sRv));
        bf16_t* dst = (col < 128) ? U + t0 * DM + h * 128 + col : WM + t0 * DM + h * 128 + (col - 128);
#pragma unroll
        for (int i = 0; i < 64; ++i) x[i] = 0.f;
#pragma unroll
        for (int i = 0; i < 64; ++i) { float v = sRv[i * 260];
#pragma unroll
            for (int jc = 0; jc < (i + 3) / 4; ++jc) { const f32x4 a = *(volatile LAS f32x4*)(sAv + i * 68 + 4 * jc);
                v -= a[0] * x[4 * jc]; v -= a[1] * x[4 * jc + 1]; v -= a[2] * x[4 * jc + 2]; v -= a[3] * x[4 * jc + 3]; }
            x[i] = v; dst[(size_t)i * DM] = (bf16_t)f2bf(v); __builtin_amdgcn_sched_barrier(0); } }
    __syncthreads();
}
__device__ __forceinline__ void chain_gdn(const Ctx& c, int chain, bf16_t* U, const bf16_t* WM, const bf16_t* QD, const bf16_t* KDT, const bf16_t* ATT, const float* EG) {
    const int bh = chain >> 2, sl = chain & 3, b = bh >> 3, h = bh & 7; const int mt = c.wave & 3, nt = c.wave >> 2;
    LAS bf16_t* sSt = (LAS bf16_t*)c.lds; LAS bf16_t* sVT = (LAS bf16_t*)(c.lds + 8704);
    f32x4 accS[2]; accS[0] = (f32x4){0.f, 0.f, 0.f, 0.f}; accS[1] = accS[0];
    for (int idx = c.tid; idx < 32 * 136 / 2; idx += 512) ((LAS unsigned*)sSt)[idx] = 0u;
    __syncthreads();
    for (int n = 0; n < 32; ++n) {
        const int ci = bh * 32 + n; const size_t t0 = (size_t)b * SEQ + 64 * n;
        const size_t rowA = (t0 + 16 * mt + c.r16) * DM + h * 128 + 8 * c.q;
        bf16x8 aW[4], aQd[4], aAt[2], bKd[2];
#pragma unroll
        for (int ks = 0; ks < 4; ++ks) { aW[ks] = *(const bf16x8*)(WM + rowA + 32 * ks); aQd[ks] = *(const bf16x8*)(QD + rowA + 32 * ks); }
#pragma unroll
        for (int ks = 0; ks < 2; ++ks) { aAt[ks] = *(const bf16x8*)(ATT + ((size_t)ci * 64 + 16 * mt + c.r16) * 64 + 32 * ks + 8 * c.q);
            bKd[ks] = *(const bf16x8*)(KDT + ((size_t)ci * 128 + 16 * c.wave + c.r16) * 64 + 32 * ks + 8 * c.q); }
        bf16_t* up = U + (t0 + 16 * mt + 4 * c.q) * DM + h * 128 + 32 * sl + 16 * nt + c.r16;
        float u[4];
#pragma unroll
        for (int jj = 0; jj < 4; ++jj) u[jj] = bf1(up[(size_t)jj * DM]);
        const float eg = EG[ci];
        f32x4 av = (f32x4){0.f, 0.f, 0.f, 0.f}, ao = av;
#pragma unroll
        for (int ks = 0; ks < 4; ++ks) { const bf16x8 bS = *(const LAS bf16x8*)(sSt + (16 * nt + c.r16) * 136 + 32 * ks + 8 * c.q); av = mma(aW[ks], bS, av); ao = mma(aQd[ks], bS, ao); }
        *(LAS u32x2*)(sVT + (16 * nt + c.r16) * 72 + 16 * mt + 4 * c.q) = (u32x2){pk2(u[0] - av[0], u[1] - av[1]), pk2(u[2] - av[2], u[3] - av[3])};
        __syncthreads();
#pragma unroll
        for (int ks = 0; ks < 2; ++ks) { const bf16x8 bV = *(const LAS bf16x8*)(sVT + (16 * nt + c.r16) * 72 + 32 * ks + 8 * c.q); ao = mma(aAt[ks], bV, ao); }
#pragma unroll
        for (int jj = 0; jj < 4; ++jj) up[(size_t)jj * DM] = (bf16_t)f2bf(ao[jj]);
#pragma unroll
        for (int et = 0; et < 2; ++et) { accS[et] = accS[et] * eg;
#pragma unroll
            for (int ks = 0; ks < 2; ++ks) { const bf16x8 aV = *(const LAS bf16x8*)(sVT + (16 * et + c.r16) * 72 + 32 * ks + 8 * c.q); accS[et] = mma(aV, bKd[ks], accS[et]); }
#pragma unroll
            for (int jj = 0; jj < 4; ++jj) sSt[(16 * et + 4 * c.q + jj) * 136 + 16 * c.wave + c.r16] = (bf16_t)f2bf(accS[et][jj]); }
        __syncthreads();
    }
}
__device__ __forceinline__ void ph_gdn_out(const Ctx& c, const bf16_t* O, const bf16_t* HP, const float* normw, bf16_t* MIX) {
    for (int m = c.gw; m < T; m += c.ngw) {
        const u32x4 a0 = *(const u32x4*)(O + (size_t)m * DM + 16 * c.lane), a1 = *(const u32x4*)(O + (size_t)m * DM + 16 * c.lane + 8);
        const u32x4 g0 = *(const u32x4*)(HP + (size_t)m * ODW + 3072 + 16 * c.lane), g1 = *(const u32x4*)(HP + (size_t)m * ODW + 3072 + 16 * c.lane + 8);
        float o[16], gt[16]; UNPACK8(a0, o); { float* o8 = o + 8; UNPACK8(a1, o8); } UNPACK8(g0, gt); { float* g8 = gt + 8; UNPACK8(g1, g8); }
        float ss = 0.f;
#pragma unroll
        for (int i = 0; i < 16; ++i) ss += o[i] * o[i];
        ss += __shfl_xor(ss, 1); ss += __shfl_xor(ss, 2); ss += __shfl_xor(ss, 4);
        const float rstd = 1.f / sqrtf(ss * (1.f / 128.f) + LN_EPS);
        float y[16];
#pragma unroll
        for (int i = 0; i < 16; ++i) y[i] = o[i] * rstd * normw[((16 * c.lane) & 127) + i] * silu_f(gt[i]);
        *(u32x4*)(MIX + (size_t)m * DM + 16 * c.lane) = PACK8(y); { float* y8 = y + 8; *(u32x4*)(MIX + (size_t)m * DM + 16 * c.lane + 8) = PACK8(y8); }
    }
}

#define XB_TMO      128
#define XB_XCNT(j)  (256  + 64 * (j))
#define XB_XSUB(j)  (1280 + 64 * (j))
#define XB_XGEN(j)  (2304 + 64 * (j))
#define XB_TOP      3328
#define XB_TOPGEN   3392
#define XCD_BAR_WORDS 3456
#define XB_SPIN_CAP (1u << 18)

__device__ __forceinline__ unsigned xb_ld(unsigned* p)              { return __hip_atomic_load(p, __ATOMIC_RELAXED, __HIP_MEMORY_SCOPE_AGENT); }
__device__ __forceinline__ unsigned xb_add(unsigned* p, unsigned v) { return __hip_atomic_fetch_add(p, v, __ATOMIC_RELAXED, __HIP_MEMORY_SCOPE_AGENT); }
__device__ __forceinline__ unsigned xb_xcc_id() { return (unsigned)__builtin_amdgcn_s_getreg((3 << 11) | 20) & 0xFu; }
#define XB_SPIN(cond, bar) do { unsigned _sp = 0; while (cond) { __builtin_amdgcn_s_sleep(1); \
    if ((++_sp & 255u) == 0u) { if (xb_ld(&(bar)[XB_TMO])) break; if (_sp > XB_SPIN_CAP) { atomicAdd(&(bar)[XB_TMO], 1u); break; } } } } while (0)

struct XcdBarrier {
    unsigned* bar; unsigned x;
    volatile LAS unsigned* st;
};

__device__ __forceinline__ XcdBarrier xcd_barrier_post(unsigned* bar, volatile LAS unsigned* st) {
    XcdBarrier b; b.bar = bar; b.x = xb_xcc_id(); b.st = st;
    if (threadIdx.x == 0) (void)xb_add(&bar[XB_XCNT(b.x)], 1u);
    return b;
}
__device__ __forceinline__ void xcd_barrier_complete(unsigned* bar, unsigned x, unsigned& nloc, unsigned& nx) {
    const unsigned G = gridDim.x * gridDim.y * gridDim.z;
    unsigned sum, cnt, mine, sp = 0u;
    for (;;) {
        sum = 0u; cnt = 0u; mine = 0u;
#pragma unroll
        for (unsigned j = 0; j < 16; ++j) { const unsigned c = xb_ld(&bar[XB_XCNT(j)]); sum += c; cnt += (c > 0u) ? 1u : 0u; mine = (j == x) ? c : mine; }
        if (sum == G) break;
        __builtin_amdgcn_s_sleep(1);
        if ((++sp & 255u) == 0u) { if (xb_ld(&bar[XB_TMO])) break; if (sp > XB_SPIN_CAP) { atomicAdd(&bar[XB_TMO], 1u); break; } }
    }
    nloc = mine > 0u ? mine : 1u; nx = cnt > 0u ? cnt : 1u;
}

__device__ __forceinline__ void xcd_barrier(const XcdBarrier& b) {
    asm volatile("s_waitcnt vmcnt(0)" ::: "memory");
    __syncthreads();
    if (threadIdx.x == 0) {
        unsigned* bar = b.bar;
        __builtin_amdgcn_s_waitcnt(0);
        unsigned nloc = b.st[0], nx = b.st[1];
        if (nloc == 0u) { xcd_barrier_complete(bar, b.x, nloc, nx); b.st[0] = nloc; b.st[1] = nx; }
        const unsigned old = xb_add(&bar[XB_XSUB(b.x)], 1u);
        const unsigned gen = old / nloc;
        if (old + 1u == (gen + 1u) * nloc) {
            __builtin_amdgcn_fence(__ATOMIC_RELEASE, "agent");
            asm volatile("s_waitcnt vmcnt(0)" ::: "memory");
            const unsigned og = xb_add(&bar[XB_TOP], 1u);
            const unsigned tg = og / nx;
            if (og + 1u == (tg + 1u) * nx) xb_add(&bar[XB_TOPGEN], 1u);
            else XB_SPIN(xb_ld(&bar[XB_TOPGEN]) == tg, bar);
            __builtin_amdgcn_fence(__ATOMIC_ACQUIRE, "agent");
            xb_add(&bar[XB_XGEN(b.x)], 1u);
            asm volatile("s_waitcnt vmcnt(0)" ::: "memory");
        } else {
            XB_SPIN(xb_ld(&bar[XB_XGEN(b.x)]) == gen, bar);
            __builtin_amdgcn_fence(__ATOMIC_ACQUIRE, "agent");
            asm volatile("s_waitcnt vmcnt(0)" ::: "memory");
        }
    }
    __syncthreads();
}


__device__ __forceinline__ Ctx mkctx(unsigned char* lds_raw) {
    int t = threadIdx.x; asm volatile("" : "+v"(t)); int bx = blockIdx.x; asm volatile("" : "+s"(bx)); int gx = gridDim.x; asm volatile("" : "+s"(gx));
    Ctx c; c.lds = (LAS unsigned char*)lds_raw; c.tid = t; c.lane = t & 63; c.wave = __builtin_amdgcn_readfirstlane(t >> 6); c.q = c.lane >> 4; c.r16 = c.lane & 15;
    c.gw = bx * 8 + c.wave; c.ngw = gx * 8; c.gtid = bx * 512 + t; c.nthr = gx * 512; c.bx = bx; c.gx = gx; return c;
}
__device__ __forceinline__ unsigned char* opaque_ptr(unsigned char* p) { asm volatile("" : "+s"(p)); return p; }
__global__ void __launch_bounds__(512, 2) fwd(P p) {
    extern __shared__ __attribute__((aligned(16))) unsigned char lds_raw[];
    cg::grid_group grid = cg::this_grid();
    volatile LAS unsigned* bar_st = (volatile LAS unsigned*)((LAS unsigned char*)lds_raw + (LDS_BYTES - 64));
    if (threadIdx.x < 2) bar_st[threadIdx.x] = 0u;
    __syncthreads();
    const XcdBarrier xbar = xcd_barrier_post((unsigned*)(p.ws + WS_BAR), bar_st);
#define WSB(off) (opaque_ptr(p.ws) + (off))
#define X ((float*)opaque_ptr((unsigned char*)p.out))
#define XB ((bf16_t*)WSB(WS_XB))
#define WMIN ((bf16_t*)WSB(WS_WMIN))
#define WMOUT ((bf16_t*)WSB(WS_WMOUT))
#define WUP ((bf16_t*)WSB(WS_WUP))
#define WDN ((bf16_t*)WSB(WS_WDN))
#define cosA ((float*)WSB(WS_COSA))
#define sinA ((float*)WSB(WS_SINA))
#define cosB ((float*)WSB(WS_COSB))
#define sinB ((float*)WSB(WS_SINB))
#define AB ((float*)WSB(WS_AB))
#define HP ((bf16_t*)WSB(WS_HP))
#define HU ((bf16_t*)WSB(WS_HU))
#define G ((bf16_t*)WSB(WS_G))
#define MIXE ((bf16_t*)WSB(WS_MIXE))
#define KVT ((bf16_t*)WSB(WS_KVT))
#define OG ((bf16_t*)WSB(WS_OG))
#define MLm ((float*)WSB(WS_MLM))
#define MLl ((float*)WSB(WS_MLL))
#define U ((bf16_t*)WSB(WS_U))
#define WM ((bf16_t*)WSB(WS_WM))
#define QD ((bf16_t*)WSB(WS_QD))
#define KDT ((bf16_t*)WSB(WS_KDT))
#define ATT ((bf16_t*)WSB(WS_ATT))
#define EG ((float*)WSB(WS_EG))

#define CTX const Ctx c = mkctx(lds_raw)
#ifndef REP_SYNC
#define REP_SYNC 1
#endif
#ifndef REP_E2
#define REP_E2 1
#endif
#ifndef REP_E4
#define REP_E4 1
#endif
#ifndef REP_GC
#define REP_GC 1
#endif
#ifndef REP_G1
#define REP_G1 1
#endif
#define GSYNC() do { for (int r_ = 0; r_ < REP_SYNC; ++r_) xcd_barrier(xbar); } while (0)
    { CTX; convert_mixer(c, p, 0); }
    { CTX; convert_ffn(c, p, 0); }
    { CTX; ph_copy_x(c, p.x, X, XB); }
    { CTX; ph_rot_tables(c, p.pos, cosA, sinA, cosB, sinB); }
    grid.sync();

    for (int layer = 0; layer < 4; ++layer) {
        const int jl = layer >> 1; const bool even = (layer & 1) == 0;
        if (!even) { CTX; ph_ab(c, X, p.od_w_in + (size_t)jl * DM * ODLD, AB); }
        { CTX; const int N = even ? EVW : ODW; EpiStore E{HP, N}; run_gemm(c, XB, WMIN, N, DM, E); }
        GSYNC();
        if (even) {
            { CTX; ph_rotary(c, HP, cosA, sinA, cosB, sinB); }
            GSYNC();
            for (int rep_ = 0; rep_ < REP_E2; ++rep_) { CTX; for (int it = c.bx; it < 512 + 3072; it += c.gx) {
                if (it < 512) item_ret_kv(c, it, HP, KVT);
                else { const int d = it - 512; item_dil(c, d >> 10, d & 1023, HP, OG, MLm, MLl); } } }
            GSYNC();
            { CTX; ph_ret_scan(c, KVT); }
            { CTX; ph_dil_combine(c, OG, MLm, MLl, MIXE); }
            GSYNC();
            for (int rep_ = 0; rep_ < REP_E4; ++rep_) { CTX; for (int it = c.bx; it < 512; it += c.gx) item_ret_out(c, it, HP, KVT, MIXE); }
            GSYNC();
        } else {
            for (int rep_ = 0; rep_ < REP_GC; ++rep_) { CTX; for (int it = c.bx; it < 2048; it += c.gx) { const int h = (it >> 5) & 7;
                item_gdn_chunk(c, it, HP, AB, p.od_conv_w + (size_t)jl * 4 * 3072, p.od_a_log[jl * 8 + h], p.od_dt_bias[jl * 8 + h], U, WM, QD, KDT, ATT, EG); } }
            GSYNC();
            { CTX; for (int ch = c.bx; ch < 256; ch += c.gx) chain_gdn(c, ch, U, WM, QD, KDT, ATT, EG); }
            GSYNC();
            { CTX; ph_gdn_out(c, U, HP, p.od_norm_w + jl * 128, WM); }
            GSYNC();
        }
        { CTX; EpiResid E{X}; run_gemm(c, even ? MIXE : WM, WMOUT, DM, even ? 1536 : 1024, E); }
        GSYNC();
        { CTX; ph_ln(c, X, XB, p.ln1_g + layer * DM, p.ln1_b + layer * DM); }
        if (layer < 3) { CTX; convert_mixer(c, p, layer + 1); }
        GSYNC();
        for (int rep_ = 0; rep_ < REP_G1; ++rep_) { CTX; EpiStore E{HU, FF2}; run_gemm(c, XB, WUP, FF2, DM, E); }
        GSYNC();
        { CTX; ph_convgate(c, HU, G, p.ffn_conv_w + (size_t)layer * 3 * FF2, p.ffn_conv_b + (size_t)layer * FF2); }
        GSYNC();
        { CTX; EpiResid E{X}; run_gemm(c, G, WDN, DM, FF, E); }
        GSYNC();
        { CTX; ph_ln(c, X, XB, p.ln2_g + layer * DM, p.ln2_b + layer * DM); }
        if (layer < 3) { { CTX; convert_ffn(c, p, layer + 1); } GSYNC(); }
    }
}

extern "C" void kernel_launch(void* const* d_in, const int* in_sizes, int n_in, void* d_out, int out_size, void* d_ws, size_t ws_size, hipStream_t stream) {
    static int grid = 0;
    if (grid == 0) {
        if (n_in != 18 || out_size != T * DM || ws_size < WS_NEED) { fprintf(stderr, "kernel_launch: unexpected problem (n_in %d out %d ws %zu)\n", n_in, out_size, ws_size); grid = -1; return; }
        int dev = 0, cus = 0, per_cu = 0;
        (void)hipGetDevice(&dev); (void)hipDeviceGetAttribute(&cus, hipDeviceAttributeMultiprocessorCount, dev);
        (void)hipFuncSetAttribute((const void*)fwd, hipFuncAttributeMaxDynamicSharedMemorySize, LDS_BYTES);
        (void)hipOccupancyMaxActiveBlocksPerMultiprocessor(&per_cu, (const void*)fwd, 512, LDS_BYTES);
        if (per_cu < 1) per_cu = 1;
        grid = cus * per_cu;
    }
    if (grid < 0) return;
    if (hipMemsetAsync((char*)d_ws + WS_BAR, 0, WS_BAR_BYTES, stream) != hipSuccess) { fprintf(stderr, "memset failed\n"); return; }
    P p{};
    p.x = (const float*)d_in[0]; p.pos = (const int*)d_in[1]; p.ev_w_in = (const float*)d_in[2]; p.ev_w_out = (const float*)d_in[3]; p.od_w_in = (const float*)d_in[4];
    p.od_conv_w = (const float*)d_in[5]; p.od_a_log = (const float*)d_in[6]; p.od_dt_bias = (const float*)d_in[7]; p.od_norm_w = (const float*)d_in[8]; p.od_w_out = (const float*)d_in[9];
    p.ffn_w_up = (const float*)d_in[10]; p.ffn_conv_w = (const float*)d_in[11]; p.ffn_conv_b = (const float*)d_in[12]; p.ffn_w_down = (const float*)d_in[13];
    p.ln1_g = (const float*)d_in[14]; p.ln1_b = (const float*)d_in[15]; p.ln2_g = (const float*)d_in[16]; p.ln2_b = (const float*)d_in[17];
    p.out = (float*)d_out; p.ws = (unsigned char*)d_ws;
    void* args[] = {&p};
    hipError_t e = hipLaunchCooperativeKernel((const void*)fwd, dim3(grid), dim3(512), args, LDS_BYTES, stream);
    if (e != hipSuccess) fprintf(stderr, "cooperative launch failed: %s (grid %d)\n", hipGetErrorString(e), grid);
}
```

```cpp
#include <hip/hip_runtime.h>
#include <hip/hip_cooperative_groups.h>
#include <cstdio>
namespace cg = cooperative_groups;

namespace pg8 {
#define PG8_LAS __attribute__((address_space(3)))
typedef unsigned short bf16_t;
typedef short bf16x8 __attribute__((ext_vector_type(8)));
typedef float f32x4 __attribute__((ext_vector_type(4)));
typedef unsigned u32x4 __attribute__((ext_vector_type(4)));
constexpr int BM = 256, BK = 64, HALF = 128, HTB = HALF * BK * 2  , STAGE_BYTES = 8 * HTB, NXCD = 8, WGM = 8;

__host__ __device__ __forceinline__ int lds_byte(int r, int c) { const int st = (r >> 4) * 2 + (c >> 5), rr = r & 15, cc = c & 31, ob = rr * 64 + cc * 2; return st * 1024 + (ob ^ (((ob >> 9) & 1) << 5)); }
__host__ __device__ __forceinline__ void stage_rc(int b, int& R, int& C) { const int st = b / 1024, sb = b % 1024, swz = sb ^ (((sb >> 9) & 1) << 5); R = (st >> 1) * 16 + swz / 64; C = (st & 1) * 32 + (swz % 64) / 2; }
__host__ __device__ __forceinline__ int perm32(int rho) { const int n = rho >> 4, i = rho & 15; return 8 * (i >> 2) + 4 * n + (i & 3); }

struct Unit { int pm, pn; };
struct Gemm { const bf16_t* A; const bf16_t* Bt; int M, N, K; };

struct StaticOrder {
    int nM, nN, nwg, G, c;
    __host__ __device__ void init(int M, int N, int G_, int c_) { nM = M / BM; nN = N / BM; nwg = nM * nN; G = G_; c = c_; }
    __host__ __device__ bool next(int i, Unit& u) const {
        const long L = (long)i * G + c; if (L >= nwg) return false;
        int wgid = (int)L; { const int q = nwg / NXCD, r = nwg % NXCD, xcd = wgid % NXCD, off = wgid / NXCD; wgid = (xcd < r ? xcd * (q + 1) : r * (q + 1) + (xcd - r) * q) + off; }
        const int nig = WGM * nN, gid = wgid / nig, fm = gid * WGM, gsz = (nM - fm) < WGM ? (nM - fm) : WGM;
        u.pm = fm + ((wgid % nig) % gsz); u.pn = (wgid % nig) / gsz; return true;
    }
    __device__ __forceinline__ void a_ready(const Unit&) const {}
    __device__ __forceinline__ void done(const Unit&) const {}
};
__device__ __forceinline__ unsigned cvt_pk_bf16(float lo, float hi) { unsigned r; asm volatile("v_cvt_pk_bf16_f32 %0, %1, %2" : "=v"(r) : "v"(lo), "v"(hi)); return r; }

template <class Epi, class Sched, bool STAMP = false>
__device__ __forceinline__ void gemm_phase(PG8_LAS unsigned char* lds, const Gemm g, const Sched& S, const Epi& E, unsigned long long* stamps) {
    int tid_ = threadIdx.x; asm volatile("" : "+v"(tid_));
    const int tid = tid_, wid = __builtin_amdgcn_readfirstlane(tid >> 6), lane = tid & 63, wr = wid >> 2, wc = wid & 3, fr = lane & 15, fq = lane >> 4;
    const int K = g.K, nt = K / BK;
    int ts_lo = 0, ts_hi = 0, nts = 0; const unsigned long long rt_entry = STAMP ? (unsigned long long)wall_clock64() : 0ull;
#define PG8_STAMP() do { if (STAMP && wid == 0 && nts < 64) { const unsigned long long _c = (unsigned long long)clock64(); \
        ts_lo = (lane == nts) ? (int)(unsigned)_c : ts_lo; ts_hi = (lane == nts) ? (int)(unsigned)(_c >> 32) : ts_hi; ++nts; } } while (0)
    PG8_STAMP();
    unsigned voffA[2], voffB[2];
#pragma unroll
    for (int i = 0; i < 2; ++i) { int R, C; stage_rc(tid * 16 + i * 8192, R, C); const int Rb = Epi::PERM ? ((R & ~31) + perm32(R & 31)) : R;
        voffA[i] = (unsigned)(R * K + C) * 2u; voffB[i] = (unsigned)(Rb * K + C) * 2u; }
    const size_t kstep = (size_t)(BK * 2);
    const size_t hstep = (size_t)HALF * K * 2;
    const size_t tstep = 2 * hstep;
    const unsigned ldsw = (unsigned)wid * 1024u;
    const int aoff = lds_byte(wr * 64 + fr, fq * 8), boff = lds_byte(wc * 32 + fr, fq * 8);
#define PG8_SA(b, h) (((b) * 2 + (h)) * HTB)
#define PG8_SB(b, h) ((4 + (b) * 2 + (h)) * HTB)
#define PG8_STAGE(bufoff, gbase, voff) do { _Pragma("unroll") for (int _i = 0; _i < 2; ++_i) \
        __builtin_amdgcn_global_load_lds((const unsigned*)((const char*)(gbase) + (voff)[_i]), (PG8_LAS unsigned*)(lds + (bufoff) + ldsw + _i * 8192), 16, 0, 0); } while (0)
#define PG8_LDA(dst, b, h) do { _Pragma("unroll") for (int m = 0; m < 4; ++m) _Pragma("unroll") for (int k = 0; k < 2; ++k) dst[m][k] = *(const PG8_LAS bf16x8*)(lds + PG8_SA(b, h) + aoff + m * 2048 + k * 1024); } while (0)
#define PG8_LDB(dst, b, h) do { _Pragma("unroll") for (int n = 0; n < 2; ++n) _Pragma("unroll") for (int k = 0; k < 2; ++k) dst[n][k] = *(const PG8_LAS bf16x8*)(lds + PG8_SB(b, h) + boff + n * 2048 + k * 1024); } while (0)
#define PG8_MMA(ai, bj, At, Bt) do { __builtin_amdgcn_s_setprio(1); _Pragma("unroll") for (int m = 0; m < 4; ++m) _Pragma("unroll") for (int n = 0; n < 2; ++n) _Pragma("unroll") for (int k = 0; k < 2; ++k) \
        acc[ai][bj][m][n] = __builtin_amdgcn_mfma_f32_16x16x32_bf16(Bt[n][k], At[m][k], acc[ai][bj][m][n], 0, 0, 0); __builtin_amdgcn_s_setprio(0); } while (0)
#define PG8_WAIT_V(n) asm volatile("s_waitcnt vmcnt(" #n ")" ::: "memory")
#define PG8_WAIT_L(n) asm volatile("s_waitcnt lgkmcnt(" #n ")" ::: "memory")
#define PG8_BAR __builtin_amdgcn_s_barrier()
#define PG8_SCHED __builtin_amdgcn_sched_barrier(0)
    Unit cur, nxt; int ui = 0;
    if (!S.next(0, cur)) return;
    f32x4 acc[2][2][4][2];
#pragma unroll
    for (int a = 0; a < 2; ++a)
#pragma unroll
        for (int b = 0; b < 2; ++b)
#pragma unroll
            for (int m = 0; m < 4; ++m)
#pragma unroll
                for (int n = 0; n < 2; ++n) acc[a][b][m][n] = (f32x4){0.f, 0.f, 0.f, 0.f};
    bf16x8 At[4][2], B0[2][2], B1[2][2];
    const char* cA = (const char*)g.A + (size_t)cur.pm * tstep; const char* cB = (const char*)g.Bt + (size_t)cur.pn * tstep;
    S.a_ready(cur);
    PG8_STAGE(PG8_SB(0, 0), cB, voffB); PG8_STAGE(PG8_SA(0, 0), cA, voffA); PG8_STAGE(PG8_SB(0, 1), cB + hstep, voffB); PG8_STAGE(PG8_SA(0, 1), cA + hstep, voffA);
    if (wr == 1) PG8_BAR;
    PG8_WAIT_V(4); PG8_BAR;
    PG8_STAGE(PG8_SB(1, 0), cB + kstep, voffB); PG8_STAGE(PG8_SA(1, 0), cA + kstep, voffA); PG8_STAGE(PG8_SB(1, 1), cB + hstep + kstep, voffB);
    PG8_WAIT_V(6); PG8_BAR;
    PG8_STAMP();
    for (;;) {
        const bool has_next = S.next(ui + 1, nxt);
        const char* nA = has_next ? (const char*)g.A + (size_t)nxt.pm * tstep : cA; const char* nB = has_next ? (const char*)g.Bt + (size_t)nxt.pn * tstep : cB;
        for (int t = 0; t < nt; t += 2) {
            const bool last = (t == nt - 2);
            const char* a1 = cA + (size_t)(t + 1) * kstep;
            const char* a2 = last ? nA : cA + (size_t)(t + 2) * kstep; const char* b2 = last ? nB : cB + (size_t)(t + 2) * kstep;
            const char* a3 = a2 + kstep; const char* b3 = b2 + kstep;
            if (last && has_next) S.a_ready(nxt);
            PG8_LDB(B0, 0, 0); PG8_SCHED; PG8_LDA(At, 0, 0); PG8_STAGE(PG8_SA(1, 1), a1 + hstep, voffA);
            PG8_WAIT_L(8); PG8_BAR; PG8_WAIT_L(0); PG8_MMA(0, 0, At, B0); PG8_BAR; PG8_SCHED;
            PG8_LDB(B1, 0, 1); PG8_STAGE(PG8_SB(0, 0), b2, voffB);
            PG8_BAR; PG8_WAIT_L(0); PG8_MMA(0, 1, At, B1); PG8_BAR;
            PG8_LDA(At, 0, 1); PG8_STAGE(PG8_SA(0, 0), a2, voffA);
            PG8_BAR; PG8_WAIT_L(0); PG8_MMA(1, 0, At, B0); PG8_BAR; PG8_SCHED;
            PG8_STAGE(PG8_SB(0, 1), b2 + hstep, voffB);
            PG8_WAIT_V(6); PG8_BAR; PG8_MMA(1, 1, At, B1); PG8_BAR;
            PG8_LDB(B0, 1, 0); PG8_SCHED; PG8_LDA(At, 1, 0); PG8_STAGE(PG8_SA(0, 1), a2 + hstep, voffA);
            PG8_WAIT_L(8); PG8_BAR; PG8_WAIT_L(0); PG8_MMA(0, 0, At, B0); PG8_BAR; PG8_SCHED;
            PG8_LDB(B1, 1, 1); PG8_STAGE(PG8_SB(1, 0), b3, voffB);
            PG8_BAR; PG8_WAIT_L(0); PG8_MMA(0, 1, At, B1); PG8_BAR;
            PG8_LDA(At, 1, 1); PG8_STAGE(PG8_SA(1, 0), a3, voffA);
            PG8_BAR; PG8_WAIT_L(0); PG8_MMA(1, 0, At, B0); PG8_BAR; PG8_SCHED;
            PG8_STAGE(PG8_SB(1, 1), b3 + hstep, voffB);
            PG8_WAIT_V(6); PG8_BAR; PG8_MMA(1, 1, At, B1); PG8_BAR;
        }
        PG8_STAMP();
        if constexpr (!Epi::AFTER_DRAIN) { E(acc, cur, wr, wc, fr, fq); S.done(cur); }
        PG8_STAMP();
        if (!has_next) break;
#pragma unroll
        for (int a = 0; a < 2; ++a)
#pragma unroll
            for (int b = 0; b < 2; ++b)
#pragma unroll
                for (int m = 0; m < 4; ++m)
#pragma unroll
                    for (int n = 0; n < 2; ++n) acc[a][b][m][n] = (f32x4){0.f, 0.f, 0.f, 0.f};
        cur = nxt; cA = nA; cB = nB; ++ui;
    }
    PG8_WAIT_V(0);
    if (wr == 0) PG8_BAR;
    PG8_BAR;
    if constexpr (Epi::AFTER_DRAIN) { E.fused(acc, cur, wr, wc, fr, fq, lds, wid, lane); S.done(cur); }
    PG8_STAMP();
    if (STAMP && wid == 0) { stamps[lane] = lane < nts ? (((unsigned long long)(unsigned)ts_hi << 32) | (unsigned)ts_lo) : 0ull;
        if (lane == 62) stamps[62] = rt_entry; if (lane == 63) stamps[63] = (unsigned long long)wall_clock64(); }
#undef PG8_STAMP
#undef PG8_SA
#undef PG8_SB
#undef PG8_STAGE
#undef PG8_LDA
#undef PG8_LDB
#undef PG8_MMA
#undef PG8_WAIT_V
#undef PG8_WAIT_L
#undef PG8_BAR
#undef PG8_SCHED
}
}

#define LAS __attribute__((address_space(3)))
using pg8::bf16_t; using pg8::bf16x8; using pg8::f32x4; using pg8::u32x4;
typedef unsigned u32x2 __attribute__((ext_vector_type(2)));

constexpr int T = 16384, SEQ = 2048, DM = 1024;
constexpr int EVW = 4608, ODW = 4096, ODLD = 4112, FF2 = 5632, FF = 2816;
constexpr float DN_ALPHA = 1.681792830507429f;
constexpr float LN_EPS = 1e-5f;
constexpr size_t MiB = 1u << 20;
constexpr size_t WS_EG = 65536, WS_BAR = 131072, WS_BAR_BYTES = 16384;
constexpr size_t WS_WMIN = 1 * MiB, WS_WMOUT = 10 * MiB, WS_WUP = 13 * MiB, WS_WDN = 24 * MiB;
constexpr size_t WS_XB = 30 * MiB, WS_COSA = 62 * MiB, WS_SINA = 66 * MiB, WS_COSB = 70 * MiB, WS_SINB = 70 * MiB + 512 * 1024, WS_AB = 71 * MiB;
constexpr size_t WS_BIG = 72 * MiB, WS_NEED = 352 * MiB;
constexpr size_t WS_HU = WS_BIG, WS_G = WS_BIG + 176 * MiB;
constexpr size_t WS_HP = WS_BIG, WS_MIXE = WS_BIG + 144 * MiB, WS_KVT = WS_BIG + 192 * MiB, WS_OG = WS_BIG + 224 * MiB, WS_MLM = WS_BIG + 272 * MiB, WS_MLL = WS_MLM + 1536 * 1024;
constexpr size_t WS_U = WS_BIG + 128 * MiB, WS_WM = WS_BIG + 160 * MiB, WS_QD = WS_BIG + 192 * MiB, WS_KDT = WS_BIG + 224 * MiB, WS_ATT = WS_BIG + 256 * MiB;
constexpr int LDS_BYTES = 147456;

struct P {
    const float* x; const int* pos; const float *ev_w_in, *ev_w_out, *od_w_in, *od_conv_w, *od_a_log, *od_dt_bias, *od_norm_w, *od_w_out,
        *ffn_w_up, *ffn_conv_w, *ffn_conv_b, *ffn_w_down, *ln1_g, *ln1_b, *ln2_g, *ln2_b;
    float* out; unsigned char* ws;
};
struct Ctx { LAS unsigned char* lds; int tid, lane, wave, q, r16, gw, ngw, gtid, nthr, bx, gx; };

__device__ __forceinline__ unsigned f2bf(float f) { unsigned u = __builtin_bit_cast(unsigned, f); return (u + 0x7fffu + ((u >> 16) & 1u)) >> 16; }
__device__ __forceinline__ unsigned pk2(float lo, float hi) { return f2bf(lo) | (f2bf(hi) << 16); }
__device__ __forceinline__ float bflo(unsigned w) { return __builtin_bit_cast(float, w << 16); }
__device__ __forceinline__ float bfhi(unsigned w) { return __builtin_bit_cast(float, w & 0xffff0000u); }
__device__ __forceinline__ float bf1(bf16_t b) { return __builtin_bit_cast(float, ((unsigned)b) << 16); }
#define UNPACK8(W_, F_) do { const u32x4 w_ = (W_); F_[0] = bflo(w_[0]); F_[1] = bfhi(w_[0]); F_[2] = bflo(w_[1]); F_[3] = bfhi(w_[1]); F_[4] = bflo(w_[2]); F_[5] = bfhi(w_[2]); F_[6] = bflo(w_[3]); F_[7] = bfhi(w_[3]); } while (0)
#define PACK8(F_) (u32x4){pk2(F_[0], F_[1]), pk2(F_[2], F_[3]), pk2(F_[4], F_[5]), pk2(F_[6], F_[7])}
__device__ __forceinline__ f32x4 mma(bf16x8 a, bf16x8 b, f32x4 c) { return __builtin_amdgcn_mfma_f32_16x16x32_bf16(a, b, c, 0, 0, 0); }
__device__ __forceinline__ float wave_sum(float v) {
#pragma unroll
    for (int o = 1; o < 64; o <<= 1) v += __shfl_xor(v, o);
    return v;
}
__device__ __forceinline__ float sum16(float v) { v += __shfl_xor(v, 1); v += __shfl_xor(v, 2); v += __shfl_xor(v, 4); v += __shfl_xor(v, 8); return v; }
__device__ __forceinline__ float max16(float v) { v = fmaxf(v, __shfl_xor(v, 1)); v = fmaxf(v, __shfl_xor(v, 2)); v = fmaxf(v, __shfl_xor(v, 4)); v = fmaxf(v, __shfl_xor(v, 8)); return v; }
__device__ __forceinline__ float silu_f(float x) { return x / (1.0f + __expf(-x)); }
#define LDS_WAIT() asm volatile("s_waitcnt lgkmcnt(0)" ::: "memory")

struct EpiStore {
    static constexpr bool PERM = true, AFTER_DRAIN = false;
    bf16_t* O; int ldc;
    __device__ __forceinline__ void operator()(const f32x4 (&acc)[2][2][4][2], const pg8::Unit& u, int wr, int wc, int fr, int fq) const {
        const int row0 = u.pm * 256 + wr * 64 + fr, col0 = u.pn * 256 + wc * 32 + 8 * fq;
#pragma unroll
        for (int ai = 0; ai < 2; ++ai)
#pragma unroll
            for (int m = 0; m < 4; ++m) { bf16_t* rowp = O + (size_t)(row0 + ai * 128 + m * 16) * ldc + col0;
#pragma unroll
                for (int bj = 0; bj < 2; ++bj) { const f32x4 v0 = acc[ai][bj][m][0], v1 = acc[ai][bj][m][1];
                    u32x4 w; w.x = pk2(v0[0], v0[1]); w.y = pk2(v0[2], v0[3]); w.z = pk2(v1[0], v1[1]); w.w = pk2(v1[2], v1[3]);
                    *(u32x4*)(rowp + bj * 128) = w; } }
    }
};
struct EpiResid {
    static constexpr bool PERM = false, AFTER_DRAIN = false;
    float* X; bool do_store;
    __device__ __forceinline__ void operator()(const f32x4 (&acc)[2][2][4][2], const pg8::Unit& u, int wr, int wc, int fr, int fq) const {
        const int row0 = u.pm * 256 + wr * 64 + fr, col0 = u.pn * 256 + wc * 32 + 4 * fq;
#pragma unroll
        for (int ai = 0; ai < 2; ++ai)
#pragma unroll
            for (int m = 0; m < 4; ++m) { float* rowp = X + (size_t)(row0 + ai * 128 + m * 16) * DM + col0;
#pragma unroll
                for (int bj = 0; bj < 2; ++bj)
#pragma unroll
                    for (int n = 0; n < 2; ++n) { f32x4* pp = (f32x4*)(rowp + bj * 128 + n * 16); const f32x4 r_ = *pp * DN_ALPHA + acc[ai][bj][m][n]; if (do_store) *pp = r_; } }
    }
};
template <class Epi> __device__ __forceinline__ void run_gemm(const Ctx& c, const bf16_t* A, const bf16_t* Bt, int N, int K, const Epi& E) {
    pg8::Gemm g{A, Bt, T, N, K}; pg8::StaticOrder S; S.init(T, N, c.gx, c.bx);
    pg8::gemm_phase<Epi, pg8::StaticOrder, false>((PG8_LAS unsigned char*)c.lds, g, S, E, nullptr);
}

__device__ __forceinline__ void transpose_item(const float* W, int K, int ldw, int N, bf16_t* WT, LAS float* scr, int item, int lane) {
    const int nblk = N / 32, kb = item / nblk, nb = item % nblk, k0 = 64 * kb, n0 = 32 * nb;
#pragma unroll 8
    for (int i = 0; i < 32; ++i) { const int kk = 2 * i + (lane >> 5); scr[kk * 33 + (lane & 31)] = W[(size_t)(k0 + kk) * ldw + n0 + (lane & 31)]; }
    LDS_WAIT();
    const int ch = lane & 7;
#pragma unroll
    for (int j = 0; j < 4; ++j) { const int n = (lane >> 3) + 8 * j; const LAS float* s = scr + (8 * ch) * 33 + n;
        u32x4 o; o.x = pk2(s[0 * 33], s[1 * 33]); o.y = pk2(s[2 * 33], s[3 * 33]); o.z = pk2(s[4 * 33], s[5 * 33]); o.w = pk2(s[6 * 33], s[7 * 33]);
        *(u32x4*)(WT + (size_t)(n0 + n) * K + k0 + 8 * ch) = o; }
    LDS_WAIT();
}
__device__ __forceinline__ void convert2(const Ctx& c, const float* W1, int K1, int ld1, int N1, bf16_t* WT1, const float* W2, int K2, int ld2, int N2, bf16_t* WT2) {
    LAS float* scr = (LAS float*)(c.lds + c.wave * 16384);
    const int I1 = (K1 / 64) * (N1 / 32), I2 = (K2 / 64) * (N2 / 32);
    for (int it = c.gw; it < I1 + I2; it += c.ngw) {
        if (it < I1) transpose_item(W1, K1, ld1, N1, WT1, scr, it, c.lane);
        else transpose_item(W2, K2, ld2, N2, WT2, scr, it - I1, c.lane);
    }
}
__device__ __forceinline__ void convert_mixer(const Ctx& c, const P& p, int layer) {
    const int j = layer >> 1; bf16_t* win = (bf16_t*)(p.ws + WS_WMIN); bf16_t* wout = (bf16_t*)(p.ws + WS_WMOUT);
    if ((layer & 1) == 0) convert2(c, p.ev_w_in + (size_t)j * DM * EVW, DM, EVW, EVW, win, p.ev_w_out + (size_t)j * 1536 * DM, 1536, DM, DM, wout);
    else convert2(c, p.od_w_in + (size_t)j * DM * ODLD, DM, ODLD, ODW, win, p.od_w_out + (size_t)j * DM * DM, DM, DM, DM, wout);
}
__device__ __forceinline__ void convert_ffn(const Ctx& c, const P& p, int layer) {
    convert2(c, p.ffn_w_up + (size_t)layer * DM * FF2, DM, FF2, FF2, (bf16_t*)(p.ws + WS_WUP), p.ffn_w_down + (size_t)layer * FF * DM, FF, DM, DM, (bf16_t*)(p.ws + WS_WDN));
}

__device__ __forceinline__ void ph_copy_x(const Ctx& c, const float* x, float* X, bf16_t* XB) {
    for (int m = c.gw; m < T; m += c.ngw) {
#pragma unroll
        for (int j = 0; j < 4; ++j) { const f32x4 v = ((const f32x4*)(x + (size_t)m * DM))[c.lane + 64 * j];
            ((f32x4*)(X + (size_t)m * DM))[c.lane + 64 * j] = v;
            ((u32x2*)(XB + (size_t)m * DM))[c.lane + 64 * j] = (u32x2){pk2(v[0], v[1]), pk2(v[2], v[3])}; }
    }
}
__device__ __forceinline__ void ph_ln(const Ctx& c, float* X, bf16_t* XB, const float* g, const float* b, bool do_store) {
    for (int m = c.gw; m < T; m += c.ngw) {
        f32x4* xr = (f32x4*)(X + (size_t)m * DM) + c.lane;
        f32x4 v[4]; float s = 0.f;
#pragma unroll
        for (int j = 0; j < 4; ++j) { v[j] = xr[64 * j]; s += (v[j][0] + v[j][1]) + (v[j][2] + v[j][3]); }
        const float mean = wave_sum(s) * (1.f / DM); float s2 = 0.f;
#pragma unroll
        for (int j = 0; j < 4; ++j) { v[j] = v[j] - mean; s2 += (v[j][0] * v[j][0] + v[j][1] * v[j][1]) + (v[j][2] * v[j][2] + v[j][3] * v[j][3]); }
        const float rstd = 1.f / sqrtf(wave_sum(s2) * (1.f / DM) + LN_EPS);
#pragma unroll
        for (int j = 0; j < 4; ++j) { const f32x4 gg = ((const f32x4*)g)[c.lane + 64 * j], bb = ((const f32x4*)b)[c.lane + 64 * j];
            const f32x4 y = v[j] * rstd * gg + bb; if (do_store) { xr[64 * j] = y;
            ((u32x2*)(XB + (size_t)m * DM))[c.lane + 64 * j] = (u32x2){pk2(y[0], y[1]), pk2(y[2], y[3])}; } }
    }
}
__device__ __forceinline__ void ph_rot_tables(const Ctx& c, const int* pos, float* cosA, float* sinA, float* cosB, float* sinB) {
    for (int idx = c.gtid; idx < T * 72; idx += c.nthr) {
        const int t = idx / 72, i = idx % 72; const float pf = (float)pos[t];
        float inv; if (i < 64) inv = exp2f(-(float)i * (2.0f / 128.0f) * 13.287712379549449f); else inv = exp2f(-(float)(i - 64) * (2.0f / 16.0f) * 18.931568569324174f);
        const float ang = pf * inv; const double rev = (double)ang * 0.15915494309189535; const float fr = (float)(rev - floor(rev));
        const float sn = __builtin_amdgcn_sinf(fr), cs = __builtin_amdgcn_cosf(fr);
        if (i < 64) { cosA[t * 64 + i] = cs; sinA[t * 64 + i] = sn; } else { cosB[t * 8 + i - 64] = cs; sinB[t * 8 + i - 64] = sn; }
    }
}
__device__ __forceinline__ void ph_convgate(const Ctx& c, const bf16_t* HU, bf16_t* G, const float* cw, const float* cb) {
    constexpr int RUN = 16, NCG = FF / 8;
    for (int it = c.gtid; it < (T / RUN) * NCG; it += c.nthr) {
        const int run = it / NCG, f0 = (it % NCG) * 8, t0 = run * RUN;
        float wg[3][8], wv[3][8], bg[8], bv[8], hg0[8], hg1[8], hv0[8], hv1[8];
#pragma unroll
        for (int j = 0; j < 3; ++j)
#pragma unroll
            for (int i = 0; i < 8; ++i) { wg[j][i] = cw[j * FF2 + f0 + i]; wv[j][i] = cw[j * FF2 + FF + f0 + i]; }
#pragma unroll
        for (int i = 0; i < 8; ++i) { bg[i] = cb[f0 + i]; bv[i] = cb[FF + f0 + i]; hg0[i] = hg1[i] = hv0[i] = hv1[i] = 0.f; }
        if ((t0 & (SEQ - 1)) != 0) {
            u32x4 a = *(const u32x4*)(HU + (size_t)(t0 - 2) * FF2 + f0), b = *(const u32x4*)(HU + (size_t)(t0 - 2) * FF2 + FF + f0); UNPACK8(a, hg0); UNPACK8(b, hv0);
            a = *(const u32x4*)(HU + (size_t)(t0 - 1) * FF2 + f0); b = *(const u32x4*)(HU + (size_t)(t0 - 1) * FF2 + FF + f0); UNPACK8(a, hg1); UNPACK8(b, hv1);
        }
#pragma unroll 2
        for (int tt = 0; tt < RUN; ++tt) {
            const size_t t = t0 + tt; float cg_[8], cv_[8], o[8];
            const u32x4 a = *(const u32x4*)(HU + t * FF2 + f0), b = *(const u32x4*)(HU + t * FF2 + FF + f0); UNPACK8(a, cg_); UNPACK8(b, cv_);
#pragma unroll
            for (int i = 0; i < 8; ++i) { const float yg = bg[i] + wg[0][i] * hg0[i] + wg[1][i] * hg1[i] + wg[2][i] * cg_[i]; const float yv = bv[i] + wv[0][i] * hv0[i] + wv[1][i] * hv1[i] + wv[2][i] * cv_[i];
                o[i] = silu_f(yg) * yv; hg0[i] = hg1[i]; hg1[i] = cg_[i]; hv0[i] = hv1[i]; hv1[i] = cv_[i]; }
            *(u32x4*)(G + t * FF + f0) = PACK8(o);
        }
    }
}

template <class R> __device__ __forceinline__ void stage_N(LAS bf16_t* dst, int dld, R src_row, int nrows, int ncols, int tid) {
    const int cpr = ncols >> 3, nch = nrows * cpr;
    for (int idx = tid; idx < nch; idx += 512) { const int r = idx / cpr, cc = idx % cpr; const bf16_t* s = src_row(r);
        u32x4 w = (u32x4){0u, 0u, 0u, 0u}; if (s) w = *(const u32x4*)(s + cc * 8);
        *(LAS u32x4*)(dst + r * dld + cc * 8) = w; }
}
template <class R, class F> __device__ __forceinline__ void stage_T(LAS bf16_t* dst, int dld, R src_row, int nrows, int ncols, int tid, F scale) {
    const int nch = nrows * (ncols >> 3);
    for (int idx = tid; idx < nch; idx += 512) { const int r = idx & (nrows - 1), cc = idx / nrows; const bf16_t* s = src_row(r);
        u32x4 w = (u32x4){0u, 0u, 0u, 0u}; if (s) w = *(const u32x4*)(s + cc * 8);
        float f[8]; UNPACK8(w, f); const float sc = scale(r);
#pragma unroll
        for (int i = 0; i < 8; ++i) dst[(cc * 8 + i) * dld + r] = (bf16_t)f2bf(f[i] * sc); }
}

__device__ __forceinline__ void rot8(bf16_t* p1, bf16_t* p2, const float* cs, const float* sn, float sc, bool do_store) {
    const u32x4 a = *(const u32x4*)p1, b = *(const u32x4*)p2; float x1[8], x2[8], o1[8], o2[8]; UNPACK8(a, x1); UNPACK8(b, x2);
#pragma unroll
    for (int i = 0; i < 8; ++i) { const float c_ = cs[i], s_ = sn[i]; o1[i] = (x1[i] * c_ - x2[i] * s_) * sc; o2[i] = (x2[i] * c_ + x1[i] * s_) * sc; }
    if (do_store) { *(u32x4*)p1 = PACK8(o1); *(u32x4*)p2 = PACK8(o2); }
}
__device__ __forceinline__ void ph_rotary(const Ctx& c, bf16_t* HP, const float* cosA, const float* sinA, const float* cosB, const float* sinB, bool do_store) {
    for (int idx = c.gtid; idx < T * 80; idx += c.nthr) {
        const int t = idx / 80, it = idx % 80; bf16_t* row = HP + (size_t)t * EVW;
        if (it < 64) { const int which = it >> 5, h = (it >> 3) & 3, ci = it & 7; bf16_t* p1 = row + which * 512 + h * 128 + ci * 8;
            rot8(p1, p1 + 64, cosA + t * 64 + ci * 8, sinA + t * 64 + ci * 8, which ? 0.08838834764831845f : 1.0f, do_store); }
        else if (it < 72) { const int h = it - 64; bf16_t* base = row + 3072 + h * 64; const float sc = 0.125f * 1.4426950408889634f;
            rot8(base, base + 8, cosB + t * 8, sinB + t * 8, sc, do_store);
#pragma unroll
            for (int ch = 2; ch < 8; ++ch) { const u32x4 a = *(const u32x4*)(base + ch * 8); float f[8]; UNPACK8(a, f);
#pragma unroll
                for (int i = 0; i < 8; ++i) f[i] *= sc;
                if (do_store) *(u32x4*)(base + ch * 8) = PACK8(f); } }
        else { const int h = it - 72; bf16_t* base = row + 3584 + h * 64; rot8(base, base + 8, cosB + t * 8, sinB + t * 8, 1.0f, do_store); }
    }
}

__device__ __forceinline__ float ret_lg2(int h) { return log2f(1.0f - exp2f(-5.0f - (float)h)); }
__device__ __forceinline__ void item_ret_kv(const Ctx& c, int item, const bf16_t* HP, bf16_t* KVT) {
    const int bh = item >> 4, b = bh >> 2, h = bh & 3, n = item & 15; const size_t t0 = (size_t)b * SEQ + 128 * n; const float lg2 = ret_lg2(h);
    LAS bf16_t* sKT = (LAS bf16_t*)c.lds; LAS bf16_t* sVT = (LAS bf16_t*)(c.lds + 34816);
    stage_T(sKT, 136, [&](int j) { return HP + (t0 + j) * EVW + 512 + h * 128; }, 128, 128, c.tid, [&](int j) { return exp2f((float)(127 - j) * lg2); });
    stage_T(sVT, 136, [&](int j) { return HP + (t0 + j) * EVW + 1024 + h * 256; }, 128, 256, c.tid, [&](int) { return 1.0f; });
    __syncthreads();
    f32x4 acc[16];
#pragma unroll
    for (int nt = 0; nt < 16; ++nt) acc[nt] = (f32x4){0.f, 0.f, 0.f, 0.f};
#pragma unroll
    for (int ks = 0; ks < 4; ++ks) { const bf16x8 a = *(const LAS bf16x8*)(sKT + (16 * c.wave + c.r16) * 136 + 32 * ks + 8 * c.q);
#pragma unroll
        for (int nt = 0; nt < 16; ++nt) { const bf16x8 bb = *(const LAS bf16x8*)(sVT + (16 * nt + c.r16) * 136 + 32 * ks + 8 * c.q); acc[nt] = mma(a, bb, acc[nt]); } }
#pragma unroll
    for (int nt = 0; nt < 16; ++nt) { const int e = 16 * nt + c.r16;
        *(u32x2*)(KVT + ((size_t)item * 256 + e) * 128 + 16 * c.wave + 4 * c.q) = (u32x2){pk2(acc[nt][0], acc[nt][1]), pk2(acc[nt][2], acc[nt][3])}; }
    __syncthreads();
}
__device__ __forceinline__ void ph_ret_scan(const Ctx& c, bf16_t* KVT, bool do_store) {
    for (int idx = c.gtid; idx < 32 * 4096; idx += c.nthr) {
        const int bh = idx >> 12, ch = idx & 4095, h = bh & 3; const float gch = exp2f(128.0f * ret_lg2(h));
        float st[8];
#pragma unroll
        for (int i = 0; i < 8; ++i) st[i] = 0.f;
        for (int n = 0; n < 16; ++n) { u32x4* ptr = (u32x4*)(KVT + (size_t)(bh * 16 + n) * 32768 + ch * 8); const u32x4 w = *ptr; float tmp[8]; UNPACK8(w, tmp);
            if (do_store) *ptr = PACK8(st);
#pragma unroll
            for (int i = 0; i < 8; ++i) st[i] = st[i] * gch + tmp[i]; }
    }
}
__device__ __forceinline__ void item_ret_out(const Ctx& c, int item, const bf16_t* HP, const bf16_t* RT, bf16_t* MIX) {
    const int bh = item >> 4, b = bh >> 2, h = bh & 3, n = item & 15; const size_t t0 = (size_t)b * SEQ + 128 * n; const float lg2 = ret_lg2(h);
    LAS bf16_t* sK = (LAS bf16_t*)c.lds; LAS bf16_t* sVT = (LAS bf16_t*)(c.lds + 34816); LAS bf16_t* sP = (LAS bf16_t*)(c.lds + 34816 + 69632) + c.wave * 16 * 136;
    stage_N(sK, 136, [&](int j) { return HP + (t0 + j) * EVW + 512 + h * 128; }, 128, 128, c.tid);
    stage_T(sVT, 136, [&](int j) { return HP + (t0 + j) * EVW + 1024 + h * 256; }, 128, 256, c.tid, [&](int) { return 1.0f; });
    bf16x8 aQ[4];
    { const bf16_t* qrow = HP + (t0 + 16 * c.wave + c.r16) * EVW + h * 128;
#pragma unroll
      for (int ks = 0; ks < 4; ++ks) aQ[ks] = *(const bf16x8*)(qrow + 32 * ks + 8 * c.q); }
    __syncthreads();
#pragma unroll
    for (int nt = 0; nt < 8; ++nt) {
        if (nt <= c.wave) { f32x4 s = (f32x4){0.f, 0.f, 0.f, 0.f};
#pragma unroll
            for (int ks = 0; ks < 4; ++ks) { const bf16x8 bb = *(const LAS bf16x8*)(sK + (16 * nt + c.r16) * 136 + 32 * ks + 8 * c.q); s = mma(aQ[ks], bb, s); }
#pragma unroll
            for (int jj = 0; jj < 4; ++jj) { const int i = 16 * c.wave + 4 * c.q + jj, j = 16 * nt + c.r16; const float pv = (i >= j) ? s[jj] * exp2f((float)(i - j) * lg2) : 0.f;
                sP[(4 * c.q + jj) * 136 + 16 * nt + c.r16] = (bf16_t)f2bf(pv); } }
        else if (nt == c.wave + 1) {
#pragma unroll
            for (int jj = 0; jj < 4; ++jj) sP[(4 * c.q + jj) * 136 + 16 * nt + c.r16] = (bf16_t)0; }
    }
    f32x4 acc[16];
#pragma unroll
    for (int nt = 0; nt < 16; ++nt) acc[nt] = (f32x4){0.f, 0.f, 0.f, 0.f};
    const bf16_t* rt = RT + (size_t)item * 32768;
#pragma unroll
    for (int ks = 0; ks < 4; ++ks)
#pragma unroll
        for (int nt = 0; nt < 16; ++nt) { const bf16x8 bb = *(const bf16x8*)(rt + (16 * nt + c.r16) * 128 + 32 * ks + 8 * c.q); acc[nt] = mma(aQ[ks], bb, acc[nt]); }
    {   float xi[4];
#pragma unroll
        for (int jj = 0; jj < 4; ++jj) xi[jj] = exp2f((float)(16 * c.wave + 4 * c.q + jj + 1) * lg2);
#pragma unroll
        for (int nt = 0; nt < 16; ++nt)
#pragma unroll
            for (int jj = 0; jj < 4; ++jj) acc[nt][jj] *= xi[jj]; }
    LDS_WAIT();
#pragma unroll
    for (int ks = 0; ks < 4; ++ks) {
        if (ks <= (c.wave >> 1)) { const bf16x8 a = *(const LAS bf16x8*)(sP + c.r16 * 136 + 32 * ks + 8 * c.q);
#pragma unroll
            for (int nt = 0; nt < 16; ++nt) { const bf16x8 bb = *(const LAS bf16x8*)(sVT + (16 * nt + c.r16) * 136 + 32 * ks + 8 * c.q); acc[nt] = mma(a, bb, acc[nt]); } }
    }
    float rstd[4];
#pragma unroll
    for (int jj = 0; jj < 4; ++jj) { float ss = 0.f;
#pragma unroll
        for (int nt = 0; nt < 16; ++nt) ss += acc[nt][jj] * acc[nt][jj];
        ss = sum16(ss); rstd[jj] = 1.f / sqrtf(ss * (1.f / 256.f) + LN_EPS); }
#pragma unroll
    for (int jj = 0; jj < 4; ++jj) { const size_t t = t0 + 16 * c.wave + 4 * c.q + jj;
#pragma unroll
        for (int nt = 0; nt < 16; ++nt) { const int e = 16 * nt + c.r16; const float gt = bf1(HP[t * EVW + 2048 + h * 256 + e]);
            MIX[t * 1536 + h * 256 + e] = (bf16_t)f2bf(acc[nt][jj] * rstd[jj] * silu_f(gt)); } }
    __syncthreads();
}

__device__ __forceinline__ void item_dil(const Ctx& c, int g, int ii, const bf16_t* HP, bf16_t* OG, float* MLm, float* MLl) {
    const int ld = 2 * g, d = 1 << ld;
    const int bh = ii >> 4, b = bh >> 3, h = bh & 7, rem = ii & 15, r = rem & (d - 1), j = rem >> ld;
    LAS bf16_t* sK = (LAS bf16_t*)c.lds; LAS bf16_t* sVT = (LAS bf16_t*)(c.lds + 36864); LAS bf16_t* sP = (LAS bf16_t*)(c.lds + 36864 + 35840) + c.wave * 16 * 168;
    const size_t tb = (size_t)b * SEQ;
    stage_N(sK, 72, [&](int kk) -> const bf16_t* { const int lk = 128 * (j - 1) + kk; return lk >= 0 ? HP + (tb + (size_t)lk * d + r) * EVW + 3584 + h * 64 : nullptr; }, 256, 64, c.tid);
    stage_T(sVT, 280, [&](int kk) -> const bf16_t* { const int lk = 128 * (j - 1) + kk; return lk >= 0 ? HP + (tb + (size_t)lk * d + r) * EVW + 4096 + h * 64 : nullptr; }, 256, 64, c.tid, [&](int) { return 1.0f; });
    for (int idx = c.tid; idx < 64 * 24; idx += 512) sVT[(idx / 24) * 280 + 256 + idx % 24] = (bf16_t)0;
    bf16x8 aQ[2];
    { const bf16_t* qrow = HP + (tb + (size_t)(128 * j + 16 * c.wave + c.r16) * d + r) * EVW + 3072 + h * 64;
      aQ[0] = *(const bf16x8*)(qrow + 8 * c.q); aQ[1] = *(const bf16x8*)(qrow + 32 + 8 * c.q); }
    *(LAS u32x2*)(sP + (c.lane >> 2) * 168 + 144 + 4 * (c.lane & 3)) = (u32x2){0u, 0u};
    __syncthreads();
    f32x4 s[9]; float mx[4] = {-INFINITY, -INFINITY, -INFINITY, -INFINITY};
#pragma unroll
    for (int tt = 0; tt < 9; ++tt) { const int kt = c.wave + tt; f32x4 a = (f32x4){0.f, 0.f, 0.f, 0.f};
#pragma unroll
        for (int ks = 0; ks < 2; ++ks) { const bf16x8 bb = *(const LAS bf16x8*)(sK + (16 * kt + c.r16) * 72 + 32 * ks + 8 * c.q); a = mma(aQ[ks], bb, a); }
#pragma unroll
        for (int jj = 0; jj < 4; ++jj) { const int i = 16 * c.wave + 4 * c.q + jj, kk = 16 * kt + c.r16, dist = 128 + i - kk;
            const bool ok = (dist >= 0) && (dist <= 128) && (j > 0 || kk >= 128);
            a[jj] = ok ? a[jj] : -INFINITY; mx[jj] = fmaxf(mx[jj], a[jj]); }
        s[tt] = a; }
    float l[4];
#pragma unroll
    for (int jj = 0; jj < 4; ++jj) { mx[jj] = max16(mx[jj]); l[jj] = 0.f; }
#pragma unroll
    for (int tt = 0; tt < 9; ++tt)
#pragma unroll
        for (int jj = 0; jj < 4; ++jj) { const float pv = exp2f(s[tt][jj] - mx[jj]); l[jj] += pv; sP[(4 * c.q + jj) * 168 + 16 * tt + c.r16] = (bf16_t)f2bf(pv); }
#pragma unroll
    for (int jj = 0; jj < 4; ++jj) l[jj] = sum16(l[jj]);
    LDS_WAIT();
    f32x4 o[4];
#pragma unroll
    for (int et = 0; et < 4; ++et) o[et] = (f32x4){0.f, 0.f, 0.f, 0.f};
#pragma unroll
    for (int ks = 0; ks < 5; ++ks) { const bf16x8 a = *(const LAS bf16x8*)(sP + c.r16 * 168 + 32 * ks + 8 * c.q);
#pragma unroll
        for (int et = 0; et < 4; ++et) { const bf16x8 bb = *(const LAS bf16x8*)(sVT + (16 * et + c.r16) * 280 + 16 * c.wave + 32 * ks + 8 * c.q); o[et] = mma(a, bb, o[et]); } }
#pragma unroll
    for (int jj = 0; jj < 4; ++jj) { const int i = 16 * c.wave + 4 * c.q + jj; const size_t tq = tb + (size_t)(128 * j + i) * d + r; const float inv = 1.f / l[jj];
#pragma unroll
        for (int et = 0; et < 4; ++et) OG[((size_t)g * T + tq) * 512 + h * 64 + 16 * et + c.r16] = (bf16_t)f2bf(o[et][jj] * inv);
        if (c.r16 == 0) { MLm[((size_t)g * T + tq) * 8 + h] = mx[jj]; MLl[((size_t)g * T + tq) * 8 + h] = l[jj]; } }
    __syncthreads();
}
__device__ __forceinline__ void ph_dil_combine(const Ctx& c, const bf16_t* OG, const float* MLm, const float* MLl, bf16_t* MIX) {
    for (int idx = c.gtid; idx < T * 64; idx += c.nthr) {
        const int t = idx >> 6, h = (idx >> 3) & 7, ch = idx & 7;
        float m[3], w[3];
#pragma unroll
        for (int g = 0; g < 3; ++g) { m[g] = MLm[((size_t)g * T + t) * 8 + h]; w[g] = MLl[((size_t)g * T + t) * 8 + h]; }
        const float mm = fmaxf(m[0], fmaxf(m[1], m[2])); float ws = 0.f;
#pragma unroll
        for (int g = 0; g < 3; ++g) { w[g] *= exp2f(m[g] - mm); ws += w[g]; }
        float acc[8];
#pragma unroll
        for (int i = 0; i < 8; ++i) acc[i] = 0.f;
#pragma unroll
        for (int g = 0; g < 3; ++g) { const u32x4 a = *(const u32x4*)(OG + ((size_t)g * T + t) * 512 + h * 64 + ch * 8); float f[8]; UNPACK8(a, f);
#pragma unroll
            for (int i = 0; i < 8; ++i) acc[i] += w[g] * f[i]; }
        const float inv = 1.f / ws;
#pragma unroll
        for (int i = 0; i < 8; ++i) acc[i] *= inv;
        *(u32x4*)(MIX + (size_t)t * 1536 + 1024 + h * 64 + ch * 8) = PACK8(acc);
    }
}

__device__ __forceinline__ void ph_ab(const Ctx& c, const float* X, const float* W  , float* AB) {
    LAS float* sW = (LAS float*)c.lds;
    for (int idx = c.tid; idx < 1024 * 4; idx += 512) { const int k = idx >> 2, part = idx & 3;
        *(LAS f32x4*)(sW + k * 20 + 4 * part) = *(const f32x4*)(W + (size_t)k * ODLD + ODW + 4 * part); }
    __syncthreads();
    for (int m = c.gw; m < T; m += c.ngw) {
        float v[16];
#pragma unroll
        for (int i = 0; i < 16; ++i) v[i] = 0.f;
#pragma unroll
        for (int i = 0; i < 16; ++i) { const float xv = X[(size_t)m * DM + c.lane + 64 * i]; const LAS float* wr = sW + (c.lane + 64 * i) * 20;
#pragma unroll
            for (int pp = 0; pp < 4; ++pp) { const f32x4 w4 = *(const LAS f32x4*)(wr + 4 * pp);
#pragma unroll
                for (int e = 0; e < 4; ++e) v[4 * pp + e] += w4[e] * xv; } }
        float w8[8], w4_[4], w2[2], w1;
        { const bool hi = (c.lane & 32) != 0;
#pragma unroll
          for (int i = 0; i < 8; ++i) { const float keep = hi ? v[i + 8] : v[i], send = hi ? v[i] : v[i + 8]; w8[i] = keep + __shfl_xor(send, 32); } }
        { const bool hi = (c.lane & 16) != 0;
#pragma unroll
          for (int i = 0; i < 4; ++i) { const float keep = hi ? w8[i + 4] : w8[i], send = hi ? w8[i] : w8[i + 4]; w4_[i] = keep + __shfl_xor(send, 16); } }
        { const bool hi = (c.lane & 8) != 0;
#pragma unroll
          for (int i = 0; i < 2; ++i) { const float keep = hi ? w4_[i + 2] : w4_[i], send = hi ? w4_[i] : w4_[i + 2]; w2[i] = keep + __shfl_xor(send, 8); } }
        { const bool hi = (c.lane & 4) != 0; const float keep = hi ? w2[1] : w2[0], send = hi ? w2[0] : w2[1]; w1 = keep + __shfl_xor(send, 4); }
        w1 += __shfl_xor(w1, 1); w1 += __shfl_xor(w1, 2);
        if ((c.lane & 3) == 0) { const int vi = ((c.lane >> 5) & 1) * 8 + ((c.lane >> 4) & 1) * 4 + ((c.lane >> 3) & 1) * 2 + ((c.lane >> 2) & 1); AB[(size_t)m * 16 + vi] = w1; }
    }
    __syncthreads();
}
__device__ __forceinline__ void item_gdn_chunk(const Ctx& c, int item, bool load_cw, const bf16_t* HP, const float* AB, const float* convw, float alog, float dtb,
                                               bf16_t* U, bf16_t* WM, bf16_t* QD, bf16_t* KDT, bf16_t* ATT, float* EG) {
    const int bh = item >> 5, b = bh >> 3, h = bh & 7, n = item & 31; const size_t t0 = (size_t)b * SEQ + 64 * n;
    LAS bf16_t* sQ = (LAS bf16_t*)c.lds; LAS bf16_t* sK = (LAS bf16_t*)(c.lds + 17408); LAS bf16_t* sKD = (LAS bf16_t*)(c.lds + 34816);
    LAS float* sRHS = (LAS float*)(c.lds + 53248); LAS float* sA = (LAS float*)(c.lds + 119808); LAS float* sBeta = (LAS float*)(c.lds + 137216); LAS float* sGc = (LAS float*)(c.lds + 137472);
    LAS bf16_t* sRAW = (LAS bf16_t*)(c.lds + 53248);
    LAS float* sCW = (LAS float*)(c.lds + 137728);
    if (load_cw) for (int idx = c.tid; idx < 1536; idx += 512) { const int wh = idx / 512, jt = (idx >> 7) & 3, dd = idx & 127; sCW[idx] = convw[jt * 3072 + wh * 1024 + h * 128 + dd]; }
    {   const int tin0 = (int)(t0 & (SEQ - 1));
        for (int idx = c.tid; idx < 67 * 48; idx += 512) { const int rr = idx / 48, cc = idx % 48, wh = cc >> 4, c8 = cc & 15;
            u32x4 w = (u32x4){0u, 0u, 0u, 0u}; if (tin0 - 3 + rr >= 0) w = *(const u32x4*)(HP + (t0 - 3 + rr) * ODW + wh * 1024 + h * 128 + c8 * 8);
            *(LAS u32x4*)(sRAW + rr * 392 + cc * 8) = w; } }
    if (c.wave == 0) {
        const float braw = AB[(t0 + c.lane) * 16 + h], araw = AB[(t0 + c.lane) * 16 + 8 + h] + dtb;
        const float beta = 1.f / (1.f + __expf(-braw));
        const float sp = fmaxf(araw, 0.f) + log1pf(__expf(-fabsf(araw)));
        float g = -__expf(alog) * sp;
#pragma unroll
        for (int off = 1; off < 64; off <<= 1) { const float v = __shfl_up(g, off); if (c.lane >= off) g += v; }
        sBeta[c.lane] = beta; sGc[c.lane] = g; if (c.lane == 63) EG[item] = __expf(g);
    }
    __syncthreads();
    const float glast = sGc[63];
    u32x4 yq[2], yk[2]; float yv[2][8];
#pragma unroll
    for (int which = 0; which < 3; ++which)
#pragma unroll
        for (int pass = 0; pass < 2; ++pass) {
            const int tok = 32 * pass + 4 * c.wave + c.q;
            float y[8];
#pragma unroll
            for (int i = 0; i < 8; ++i) y[i] = 0.f;
#pragma unroll
            for (int jt = 0; jt < 4; ++jt) { const u32x4 w = *(const LAS u32x4*)(sRAW + (tok + jt) * 392 + which * 128 + 8 * c.r16); float f[8]; UNPACK8(w, f);
                const f32x4 c0 = *(const LAS f32x4*)(sCW + (which * 4 + jt) * 128 + 8 * c.r16), c1 = *(const LAS f32x4*)(sCW + (which * 4 + jt) * 128 + 8 * c.r16 + 4);
#pragma unroll
                for (int i = 0; i < 4; ++i) { y[i] += c0[i] * f[i]; y[4 + i] += c1[i] * f[4 + i]; } }
#pragma unroll
            for (int i = 0; i < 8; ++i) y[i] = silu_f(y[i]);
            if (which < 2) { float ss = 0.f;
#pragma unroll
                for (int i = 0; i < 8; ++i) ss += y[i] * y[i];
                ss = sum16(ss); const float rn = (1.f / sqrtf(ss + 1e-6f)) * (which == 0 ? 0.08838834764831845f : 1.0f);
#pragma unroll
                for (int i = 0; i < 8; ++i) y[i] *= rn; }
            if (which == 0) yq[pass] = PACK8(y); else if (which == 1) yk[pass] = PACK8(y); else {
#pragma unroll
                for (int i = 0; i < 8; ++i) yv[pass][i] = y[i]; }
        }
    __syncthreads();
#pragma unroll
    for (int which = 0; which < 3; ++which)
#pragma unroll
        for (int pass = 0; pass < 2; ++pass) {
            const int tok = 32 * pass + 4 * c.wave + c.q; const size_t t = t0 + tok;
            float y[8];
            if (which == 0) UNPACK8(yq[pass], y); else if (which == 1) UNPACK8(yk[pass], y); else {
#pragma unroll
                for (int i = 0; i < 8; ++i) y[i] = yv[pass][i]; }
            const float gcv = sGc[tok], betav = sBeta[tok];
            if (which == 0) { *(LAS u32x4*)(sQ + tok * 136 + 8 * c.r16) = yq[pass]; const float eg = __expf(gcv); float z[8];
#pragma unroll
                for (int i = 0; i < 8; ++i) z[i] = y[i] * eg;
                *(u32x4*)(QD + t * DM + h * 128 + 8 * c.r16) = PACK8(z); }
            else if (which == 1) { *(LAS u32x4*)(sK + tok * 136 + 8 * c.r16) = yk[pass]; const float e1 = betav * __expf(gcv), e2 = __expf(glast - gcv);
#pragma unroll
                for (int i = 0; i < 8; ++i) { sRHS[tok * 260 + 128 + 8 * c.r16 + i] = y[i] * e1; sKD[(8 * c.r16 + i) * 72 + tok] = (bf16_t)f2bf(y[i] * e2); } }
            else {
#pragma unroll
                for (int i = 0; i < 8; ++i) sRHS[tok * 260 + 8 * c.r16 + i] = y[i] * betav; }
        }
    __syncthreads();
#pragma unroll
    for (int ts = 0; ts < 2; ++ts) { const int idx = 2 * c.wave + ts, mt = idx >> 2, nt = idx & 3; f32x4 aK = (f32x4){0.f, 0.f, 0.f, 0.f}, aQ = aK;
#pragma unroll
        for (int ks = 0; ks < 4; ++ks) { const bf16x8 ak = *(const LAS bf16x8*)(sK + (16 * mt + c.r16) * 136 + 32 * ks + 8 * c.q), aq = *(const LAS bf16x8*)(sQ + (16 * mt + c.r16) * 136 + 32 * ks + 8 * c.q),
                bb = *(const LAS bf16x8*)(sK + (16 * nt + c.r16) * 136 + 32 * ks + 8 * c.q); aK = mma(ak, bb, aK); aQ = mma(aq, bb, aQ); }
#pragma unroll
        for (int jj = 0; jj < 4; ++jj) { const int i = 16 * mt + 4 * c.q + jj, jx = 16 * nt + c.r16; const float dec = (i >= jx) ? __expf(sGc[i] - sGc[jx]) : 0.f;
            sA[i * 68 + jx] = (i > jx) ? sBeta[i] * aK[jj] * dec : 0.f;
            ATT[((size_t)item * 64 + i) * 64 + jx] = (bf16_t)f2bf(aQ[jj] * dec); } }
    for (int idx = c.tid; idx < 1024; idx += 512) { const int dd = idx >> 3, cc = idx & 7; *(u32x4*)(KDT + ((size_t)item * 128 + dd) * 64 + cc * 8) = *(const LAS u32x4*)(sKD + dd * 72 + cc * 8); }
    __syncthreads();
    {
        const int col = c.tid >> 1, half = c.tid & 1; const bool own0 = (half == 0);
        float xs[32];
        LAS float* sAv = sA + 4 * half; asm volatile("" : "+v"(sAv)); LAS float* sRv = sRHS + col; asm volatile("" : "+v"(sRv));
        bf16_t* dst = (col < 128) ? U + t0 * DM + h * 128 + col : WM + t0 * DM + h * 128 + (col - 128);
#pragma unroll
        for (int i = 0; i < 32; ++i) xs[i] = 0.f;
#pragma unroll
        for (int i = 0; i < 64; ++i) { float v = sRv[i * 260]; v = own0 ? v : 0.f;
#pragma unroll
            for (int jj = 0; jj < (i + 7) / 8; ++jj) { const f32x4 a = *(volatile LAS f32x4*)(sAv + i * 68 + 8 * jj);
                v -= a[0] * xs[4 * jj]; v -= a[1] * xs[4 * jj + 1]; v -= a[2] * xs[4 * jj + 2]; v -= a[3] * xs[4 * jj + 3]; }
            v += __shfl_xor(v, 1);
            { const bool mine = (((i >> 2) & 1) == 0) == own0; const int slot = (i >> 3) * 4 + (i & 3); xs[slot] = mine ? v : xs[slot]; }
            if (own0) dst[(size_t)i * DM] = (bf16_t)f2bf(v);
            __builtin_amdgcn_sched_barrier(0); } }
    __syncthreads();
}
__device__ __forceinline__ void chain_gdn(const Ctx& c, int chain, bf16_t* U, const bf16_t* WM, const bf16_t* QD, const bf16_t* KDT, const bf16_t* ATT, const float* EG, bool do_store) {
    const int bh = chain >> 2, sl = chain & 3, b = bh >> 3, h = bh & 7; const int mt = c.wave & 3, nt = c.wave >> 2;
    LAS bf16_t* sSt = (LAS bf16_t*)c.lds; LAS bf16_t* sVT = (LAS bf16_t*)(c.lds + 8704);
    f32x4 accS[2]; accS[0] = (f32x4){0.f, 0.f, 0.f, 0.f}; accS[1] = accS[0];
    for (int idx = c.tid; idx < 32 * 136 / 2; idx += 512) ((LAS unsigned*)sSt)[idx] = 0u;
    __syncthreads();
    for (int n = 0; n < 32; ++n) {
        const int ci = bh * 32 + n; const size_t t0 = (size_t)b * SEQ + 64 * n;
        const size_t rowA = (t0 + 16 * mt + c.r16) * DM + h * 128 + 8 * c.q;
        bf16x8 aW[4], aQd[4], aAt[2], bKd[2];
#pragma unroll
        for (int ks = 0; ks < 4; ++ks) { aW[ks] = *(const bf16x8*)(WM + rowA + 32 * ks); aQd[ks] = *(const bf16x8*)(QD + rowA + 32 * ks); }
#pragma unroll
        for (int ks = 0; ks < 2; ++ks) { aAt[ks] = *(const bf16x8*)(ATT + ((size_t)ci * 64 + 16 * mt + c.r16) * 64 + 32 * ks + 8 * c.q);
            bKd[ks] = *(const bf16x8*)(KDT + ((size_t)ci * 128 + 16 * c.wave + c.r16) * 64 + 32 * ks + 8 * c.q); }
        bf16_t* up = U + (t0 + 16 * mt + 4 * c.q) * DM + h * 128 + 32 * sl + 16 * nt + c.r16;
        float u[4];
#pragma unroll
        for (int jj = 0; jj < 4; ++jj) u[jj] = bf1(up[(size_t)jj * DM]);
        const float eg = EG[ci];
        f32x4 av = (f32x4){0.f, 0.f, 0.f, 0.f}, ao = av;
#pragma unroll
        for (int ks = 0; ks < 4; ++ks) { const bf16x8 bS = *(const LAS bf16x8*)(sSt + (16 * nt + c.r16) * 136 + 32 * ks + 8 * c.q); av = mma(aW[ks], bS, av); ao = mma(aQd[ks], bS, ao); }
        *(LAS u32x2*)(sVT + (16 * nt + c.r16) * 72 + 16 * mt + 4 * c.q) = (u32x2){pk2(u[0] - av[0], u[1] - av[1]), pk2(u[2] - av[2], u[3] - av[3])};
        __syncthreads();
#pragma unroll
        for (int ks = 0; ks < 2; ++ks) { const bf16x8 bV = *(const LAS bf16x8*)(sVT + (16 * nt + c.r16) * 72 + 32 * ks + 8 * c.q); ao = mma(aAt[ks], bV, ao); }
#pragma unroll
        for (int jj = 0; jj < 4; ++jj) if (do_store) up[(size_t)jj * DM] = (bf16_t)f2bf(ao[jj]);
#pragma unroll
        for (int et = 0; et < 2; ++et) { accS[et] = accS[et] * eg;
#pragma unroll
            for (int ks = 0; ks < 2; ++ks) { const bf16x8 aV = *(const LAS bf16x8*)(sVT + (16 * et + c.r16) * 72 + 32 * ks + 8 * c.q); accS[et] = mma(aV, bKd[ks], accS[et]); }
#pragma unroll
            for (int jj = 0; jj < 4; ++jj) sSt[(16 * et + 4 * c.q + jj) * 136 + 16 * c.wave + c.r16] = (bf16_t)f2bf(accS[et][jj]); }
        __syncthreads();
    }
}
__device__ __forceinline__ void ph_gdn_out(const Ctx& c, const bf16_t* O, const bf16_t* HP, const float* normw, bf16_t* MIX) {
    for (int m = c.gw; m < T; m += c.ngw) {
        const u32x4 a0 = *(const u32x4*)(O + (size_t)m * DM + 16 * c.lane), a1 = *(const u32x4*)(O + (size_t)m * DM + 16 * c.lane + 8);
        const u32x4 g0 = *(const u32x4*)(HP + (size_t)m * ODW + 3072 + 16 * c.lane), g1 = *(const u32x4*)(HP + (size_t)m * ODW + 3072 + 16 * c.lane + 8);
        float o[16], gt[16]; UNPACK8(a0, o); { float* o8 = o + 8; UNPACK8(a1, o8); } UNPACK8(g0, gt); { float* g8 = gt + 8; UNPACK8(g1, g8); }
        float ss = 0.f;
#pragma unroll
        for (int i = 0; i < 16; ++i) ss += o[i] * o[i];
        ss += __shfl_xor(ss, 1); ss += __shfl_xor(ss, 2); ss += __shfl_xor(ss, 4);
        const float rstd = 1.f / sqrtf(ss * (1.f / 128.f) + LN_EPS);
        float y[16];
#pragma unroll
        for (int i = 0; i < 16; ++i) y[i] = o[i] * rstd * normw[((16 * c.lane) & 127) + i] * silu_f(gt[i]);
        *(u32x4*)(MIX + (size_t)m * DM + 16 * c.lane) = PACK8(y); { float* y8 = y + 8; *(u32x4*)(MIX + (size_t)m * DM + 16 * c.lane + 8) = PACK8(y8); }
    }
}

#define XB_TMO      128
#define XB_XCNT(j)  (256  + 64 * (j))
#define XB_XSUB(j)  (1280 + 64 * (j))
#define XB_XGEN(j)  (2304 + 64 * (j))
#define XB_TOP      3328
#define XB_TOPGEN   3392
#define XCD_BAR_WORDS 3456
#define XB_SPIN_CAP (1u << 18)

__device__ __forceinline__ unsigned xb_ld(unsigned* p)              { return __hip_atomic_load(p, __ATOMIC_RELAXED, __HIP_MEMORY_SCOPE_AGENT); }
__device__ __forceinline__ unsigned xb_add(unsigned* p, unsigned v) { return __hip_atomic_fetch_add(p, v, __ATOMIC_RELAXED, __HIP_MEMORY_SCOPE_AGENT); }
__device__ __forceinline__ unsigned xb_xcc_id() { return (unsigned)__builtin_amdgcn_s_getreg((3 << 11) | 20) & 0xFu; }
#define XB_SPIN(cond, bar) do { unsigned _sp = 0; while (cond) { __builtin_amdgcn_s_sleep(1); \
    if ((++_sp & 255u) == 0u) { if (xb_ld(&(bar)[XB_TMO])) break; if (_sp > XB_SPIN_CAP) { atomicAdd(&(bar)[XB_TMO], 1u); break; } } } } while (0)

struct XcdBarrier {
    unsigned* bar; unsigned x;
    volatile LAS unsigned* st;
};

__device__ __forceinline__ XcdBarrier xcd_barrier_post(unsigned* bar, volatile LAS unsigned* st) {
    XcdBarrier b; b.bar = bar; b.x = xb_xcc_id(); b.st = st;
    if (threadIdx.x == 0) (void)xb_add(&bar[XB_XCNT(b.x)], 1u);
    return b;
}
__device__ __forceinline__ void xcd_barrier_complete(unsigned* bar, unsigned x, unsigned& nloc, unsigned& nx) {
    const unsigned G = gridDim.x * gridDim.y * gridDim.z;
    unsigned sum, cnt, mine, sp = 0u;
    for (;;) {
        sum = 0u; cnt = 0u; mine = 0u;
#pragma unroll
        for (unsigned j = 0; j < 16; ++j) { const unsigned c = xb_ld(&bar[XB_XCNT(j)]); sum += c; cnt += (c > 0u) ? 1u : 0u; mine = (j == x) ? c : mine; }
        if (sum == G) break;
        __builtin_amdgcn_s_sleep(1);
        if ((++sp & 255u) == 0u) { if (xb_ld(&bar[XB_TMO])) break; if (sp > XB_SPIN_CAP) { atomicAdd(&bar[XB_TMO], 1u); break; } }
    }
    nloc = mine > 0u ? mine : 1u; nx = cnt > 0u ? cnt : 1u;
}

__device__ __forceinline__ void xcd_barrier(const XcdBarrier& b) {
    asm volatile("s_waitcnt vmcnt(0)" ::: "memory");
    __syncthreads();
    if (threadIdx.x == 0) {
        unsigned* bar = b.bar;
        __builtin_amdgcn_s_waitcnt(0);
        unsigned nloc = b.st[0], nx = b.st[1];
        if (nloc == 0u) { xcd_barrier_complete(bar, b.x, nloc, nx); b.st[0] = nloc; b.st[1] = nx; }
        const unsigned old = xb_add(&bar[XB_XSUB(b.x)], 1u);
        const unsigned gen = old / nloc;
        if (old + 1u == (gen + 1u) * nloc) {
            __builtin_amdgcn_fence(__ATOMIC_RELEASE, "agent");
            asm volatile("s_waitcnt vmcnt(0)" ::: "memory");
            const unsigned og = xb_add(&bar[XB_TOP], 1u);
            const unsigned tg = og / nx;
            if (og + 1u == (tg + 1u) * nx) xb_add(&bar[XB_TOPGEN], 1u);
            else XB_SPIN(xb_ld(&bar[XB_TOPGEN]) == tg, bar);
            __builtin_amdgcn_fence(__ATOMIC_ACQUIRE, "agent");
            xb_add(&bar[XB_XGEN(b.x)], 1u);
            asm volatile("s_waitcnt vmcnt(0)" ::: "memory");
        } else {
            XB_SPIN(xb_ld(&bar[XB_XGEN(b.x)]) == gen, bar);
            __builtin_amdgcn_fence(__ATOMIC_ACQUIRE, "agent");
            asm volatile("s_waitcnt vmcnt(0)" ::: "memory");
        }
    }
    __syncthreads();
}


__device__ __forceinline__ Ctx mkctx(unsigned char* lds_raw) {
    int t = threadIdx.x; asm volatile("" : "+v"(t)); int bx = blockIdx.x; asm volatile("" : "+s"(bx)); int gx = gridDim.x; asm volatile("" : "+s"(gx));
    Ctx c; c.lds = (LAS unsigned char*)lds_raw; c.tid = t; c.lane = t & 63; c.wave = __builtin_amdgcn_readfirstlane(t >> 6); c.q = c.lane >> 4; c.r16 = c.lane & 15;
    c.gw = bx * 8 + c.wave; c.ngw = gx * 8; c.gtid = bx * 512 + t; c.nthr = gx * 512; c.bx = bx; c.gx = gx; return c;
}
__device__ __forceinline__ unsigned char* opaque_ptr(unsigned char* p) { asm volatile("" : "+s"(p)); return p; }
__global__ void __launch_bounds__(512, 2) fwd(P p) {
    extern __shared__ __attribute__((aligned(16))) unsigned char lds_raw[];
    cg::grid_group grid = cg::this_grid();
    volatile LAS unsigned* bar_st = (volatile LAS unsigned*)((LAS unsigned char*)lds_raw + (LDS_BYTES - 64));
    if (threadIdx.x < 2) bar_st[threadIdx.x] = 0u;
    __syncthreads();
    const XcdBarrier xbar = xcd_barrier_post((unsigned*)(p.ws + WS_BAR), bar_st);
#define WSB(off) (opaque_ptr(p.ws) + (off))
#define X ((float*)opaque_ptr((unsigned char*)p.out))
#define XB ((bf16_t*)WSB(WS_XB))
#define WMIN ((bf16_t*)WSB(WS_WMIN))
#define WMOUT ((bf16_t*)WSB(WS_WMOUT))
#define WUP ((bf16_t*)WSB(WS_WUP))
#define WDN ((bf16_t*)WSB(WS_WDN))
#define cosA ((float*)WSB(WS_COSA))
#define sinA ((float*)WSB(WS_SINA))
#define cosB ((float*)WSB(WS_COSB))
#define sinB ((float*)WSB(WS_SINB))
#define AB ((float*)WSB(WS_AB))
#define HP ((bf16_t*)WSB(WS_HP))
#define HU ((bf16_t*)WSB(WS_HU))
#define G ((bf16_t*)WSB(WS_G))
#define MIXE ((bf16_t*)WSB(WS_MIXE))
#define KVT ((bf16_t*)WSB(WS_KVT))
#define OG ((bf16_t*)WSB(WS_OG))
#define MLm ((float*)WSB(WS_MLM))
#define MLl ((float*)WSB(WS_MLL))
#define U ((bf16_t*)WSB(WS_U))
#define WM ((bf16_t*)WSB(WS_WM))
#define QD ((bf16_t*)WSB(WS_QD))
#define KDT ((bf16_t*)WSB(WS_KDT))
#define ATT ((bf16_t*)WSB(WS_ATT))
#define EG ((float*)WSB(WS_EG))

#define CTX const Ctx c = mkctx(lds_raw)
#ifndef REP_SYNC
#define REP_SYNC 1
#endif
#ifndef REP_E2
#define REP_E2 1
#endif
#ifndef REP_E4
#define REP_E4 1
#endif
#ifndef REP_GC
#define REP_GC 1
#endif
#ifndef REP_G1
#define REP_G1 1
#endif
#ifndef REP_CG
#define REP_CG 1
#endif
#ifndef REP_CH
#define REP_CH 1
#endif
#ifndef REP_SM
#define REP_SM 1
#endif
#ifndef REP_MISC
#define REP_MISC 1
#endif
#ifndef REP_G0
#define REP_G0 1
#endif
#ifndef REP_GR
#define REP_GR 1
#endif
#define GSYNC() do { for (int r_ = 0; r_ < REP_SYNC; ++r_) xcd_barrier(xbar); } while (0)
    for (int rep_ = 0; rep_ < REP_MISC; ++rep_) {
    { CTX; convert_mixer(c, p, 0); }
    { CTX; convert_ffn(c, p, 0); }
    { CTX; ph_copy_x(c, p.x, X, XB); }
    { CTX; ph_rot_tables(c, p.pos, cosA, sinA, cosB, sinB); } }
    grid.sync();

    for (int layer = 0; layer < 4; ++layer) {
        const int jl = layer >> 1; const bool even = (layer & 1) == 0;
        if (!even) for (int rep_ = 0; rep_ < REP_SM; ++rep_) { CTX; ph_ab(c, X, p.od_w_in + (size_t)jl * DM * ODLD, AB); }
        for (int rep_ = 0; rep_ < REP_G0; ++rep_) { CTX; const int N = even ? EVW : ODW; EpiStore E{HP, N}; run_gemm(c, XB, WMIN, N, DM, E); }
        GSYNC();
        if (even) {
            for (int rep_ = 0; rep_ < REP_MISC; ++rep_) { CTX; ph_rotary(c, HP, cosA, sinA, cosB, sinB, rep_ == REP_MISC - 1); }
            GSYNC();
            for (int rep_ = 0; rep_ < REP_E2; ++rep_) { CTX; for (int it = c.bx; it < 512 + 3072; it += c.gx) {
                if (it < 512) item_ret_kv(c, it, HP, KVT);
                else { const int d = it - 512; item_dil(c, d >> 10, d & 1023, HP, OG, MLm, MLl); } } }
            GSYNC();
            for (int rep_ = 0; rep_ < REP_MISC; ++rep_) { CTX; ph_ret_scan(c, KVT, rep_ == REP_MISC - 1); }
            for (int rep_ = 0; rep_ < REP_SM; ++rep_) { CTX; ph_dil_combine(c, OG, MLm, MLl, MIXE); }
            GSYNC();
            for (int rep_ = 0; rep_ < REP_E4; ++rep_) { CTX; for (int it = c.bx; it < 512; it += c.gx) item_ret_out(c, it, HP, KVT, MIXE); }
            GSYNC();
        } else {
            for (int rep_ = 0; rep_ < REP_GC; ++rep_) { for (int it = blockIdx.x; it < 2048; it += gridDim.x) { CTX; const int h = (it >> 5) & 7;
                item_gdn_chunk(c, it, it == c.bx, HP, AB, p.od_conv_w + (size_t)jl * 4 * 3072, p.od_a_log[jl * 8 + h], p.od_dt_bias[jl * 8 + h], U, WM, QD, KDT, ATT, EG); } }
            GSYNC();
            for (int rep_ = 0; rep_ < REP_CH; ++rep_) { CTX; for (int ch = c.bx; ch < 256; ch += c.gx) chain_gdn(c, ch, U, WM, QD, KDT, ATT, EG, rep_ == REP_CH - 1); }
            GSYNC();
            for (int rep_ = 0; rep_ < REP_SM; ++rep_) { CTX; ph_gdn_out(c, U, HP, p.od_norm_w + jl * 128, WM); }
            GSYNC();
        }
        for (int rep_ = 0; rep_ < REP_GR; ++rep_) { CTX; EpiResid E{X, rep_ == REP_GR - 1}; run_gemm(c, even ? MIXE : WM, WMOUT, DM, even ? 1536 : 1024, E); }
        GSYNC();
        for (int rep_ = 0; rep_ < REP_MISC; ++rep_) { { CTX; ph_ln(c, X, XB, p.ln1_g + layer * DM, p.ln1_b + layer * DM, rep_ == REP_MISC - 1); }
        if (layer < 3) { CTX; convert_mixer(c, p, layer + 1); } }
        GSYNC();
        for (int rep_ = 0; rep_ < REP_G1; ++rep_) { CTX; EpiStore E{HU, FF2}; run_gemm(c, XB, WUP, FF2, DM, E); }
        GSYNC();
        for (int rep_ = 0; rep_ < REP_CG; ++rep_) { CTX; ph_convgate(c, HU, G, p.ffn_conv_w + (size_t)layer * 3 * FF2, p.ffn_conv_b + (size_t)layer * FF2); }
        GSYNC();
        for (int rep_ = 0; rep_ < REP_GR; ++rep_) { CTX; EpiResid E{X, rep_ == REP_GR - 1}; run_gemm(c, G, WDN, DM, FF, E); }
        GSYNC();
        for (int rep_ = 0; rep_ < REP_MISC; ++rep_) { { CTX; ph_ln(c, X, XB, p.ln2_g + layer * DM, p.ln2_b + layer * DM, rep_ == REP_MISC - 1); }
        if (layer < 3) { CTX; convert_ffn(c, p, layer + 1); } }
        if (layer < 3) GSYNC();
    }
}

extern "C" void kernel_launch(void* const* d_in, const int* in_sizes, int n_in, void* d_out, int out_size, void* d_ws, size_t ws_size, hipStream_t stream) {
    static int grid = 0;
    if (grid == 0) {
        if (n_in != 18 || out_size != T * DM || ws_size < WS_NEED) { fprintf(stderr, "kernel_launch: unexpected problem (n_in %d out %d ws %zu)\n", n_in, out_size, ws_size); grid = -1; return; }
        int dev = 0, cus = 0, per_cu = 0;
        (void)hipGetDevice(&dev); (void)hipDeviceGetAttribute(&cus, hipDeviceAttributeMultiprocessorCount, dev);
        (void)hipFuncSetAttribute((const void*)fwd, hipFuncAttributeMaxDynamicSharedMemorySize, LDS_BYTES);
        (void)hipOccupancyMaxActiveBlocksPerMultiprocessor(&per_cu, (const void*)fwd, 512, LDS_BYTES);
        if (per_cu < 1) per_cu = 1;
        grid = cus * per_cu;
    }
    if (grid < 0) return;
    if (hipMemsetAsync((char*)d_ws + WS_BAR, 0, WS_BAR_BYTES, stream) != hipSuccess) { fprintf(stderr, "memset failed\n"); return; }
    P p{};
    p.x = (const float*)d_in[0]; p.pos = (const int*)d_in[1]; p.ev_w_in = (const float*)d_in[2]; p.ev_w_out = (const float*)d_in[3]; p.od_w_in = (const float*)d_in[4];
    p.od_conv_w = (const float*)d_in[5]; p.od_a_log = (const float*)d_in[6]; p.od_dt_bias = (const float*)d_in[7]; p.od_norm_w = (const float*)d_in[8]; p.od_w_out = (const float*)d_in[9];
    p.ffn_w_up = (const float*)d_in[10]; p.ffn_conv_w = (const float*)d_in[11]; p.ffn_conv_b = (const float*)d_in[12]; p.ffn_w_down = (const float*)d_in[13];
    p.ln1_g = (const float*)d_in[14]; p.ln1_b = (const float*)d_in[15]; p.ln2_g = (const float*)d_in[16]; p.ln2_b = (const float*)d_in[17];
    p.out = (float*)d_out; p.ws = (unsigned char*)d_ws;
    void* args[] = {&p};
    hipError_t e = hipLaunchCooperativeKernel((const void*)fwd, dim3(grid), dim3(512), args, LDS_BYTES, stream);
    if (e != hipSuccess) fprintf(stderr, "cooperative launch failed: %s (grid %d)\n", hipGetErrorString(e), grid);
}
```
